# Optimizing an MI355X kernel written in HIP

```python
import math
import jax
import jax.numpy as jnp
from jax import lax
import numpy as np

D_MODEL = 1024
BATCH = 4
SEQ = 4096
DEPTH = 2

N_EVEN = (DEPTH + 1) // 2
N_ODD = DEPTH // 2
NORM_EPS = 1e-6

HG_DK = 128
HG_HEADS = D_MODEL // HG_DK
HG_WIDTH = HG_HEADS * HG_DK
HG_CHUNK = 64

SSM_HEADDIM = 64
SSM_HEADS = D_MODEL // SSM_HEADDIM
SSM_WIDTH = SSM_HEADS * SSM_HEADDIM
SSM_GROUPS = 2
SSM_STATE = 128
SSM_CONV = 4
SSM_CHUNK = 64
SSM_XBC = SSM_WIDTH + 2 * SSM_GROUPS * SSM_STATE

IN_SIZES = (HG_WIDTH, HG_WIDTH, HG_WIDTH, HG_WIDTH, SSM_WIDTH, SSM_XBC, SSM_HEADS)
IN_COLS = 4 * HG_WIDTH + SSM_WIDTH + SSM_XBC + SSM_HEADS
MIX_WIDTH = HG_WIDTH + SSM_WIDTH

RW_HEADSIZE = 64
RW_HEADS = D_MODEL // RW_HEADSIZE
RW_DECAY_LORA = 64
RW_AAA_LORA = 64
RW_GATE_LORA = 128
RW_GN_EPS = 64e-5

N_EXPERTS = 16
N_EXPERT_GROUPS = 4
EXPERTS_PER_GROUP = N_EXPERTS // N_EXPERT_GROUPS
TOP_K = 2
D_EXPERT = D_MODEL // 2

kernel_name = "hybrid_hgrn2_ssd_rwkv7_grouped_moe"


def group_rms_norm(x, w, n_groups):
    shp = x.shape
    xg = x.astype(jnp.float32).reshape(shp[:-1] + (n_groups, shp[-1] // n_groups))
    y = xg * lax.rsqrt(jnp.mean(xg * xg, axis=-1, keepdims=True) + NORM_EPS)
    return (y.reshape(shp) * w.astype(jnp.float32)).astype(x.dtype)


def rms_norm(x, w):
    return group_rms_norm(x, w, 1)


def modulate(h, shift, scale):
    return h * (1.0 + scale[:, None, :]) + shift[:, None, :]


def causal_dwconv(x, w, b):
    k = w.shape[0]
    y = lax.conv_general_dilated(x, w[:, None, :].astype(x.dtype), window_strides=(1,),
                                 padding=[(k - 1, 0)], dimension_numbers=('NWC', 'WIO', 'NWC'),
                                 feature_group_count=x.shape[-1])
    return y + b


def segsum(x):
    t = x.shape[-1]
    idx = jnp.arange(t)
    xe = jnp.broadcast_to(x[..., :, None], x.shape + (t,))
    cs = jnp.cumsum(jnp.where(idx[:, None] > idx[None, :], xe, 0.0), axis=-2)
    return jnp.where(idx[:, None] >= idx[None, :], cs, -jnp.inf)


def hgrn2_chunk_scan(q, k, v, log_f):
    bsz, s_len, h, dk = q.shape
    dv = v.shape[-1]
    nc = s_len // HG_CHUNK

    def to_chunks(t):
        return t.reshape(bsz, nc, HG_CHUNK, h, t.shape[-1]).transpose(1, 0, 3, 2, 4)

    causal = jnp.tril(jnp.ones((HG_CHUNK, HG_CHUNK), dtype=bool))

    def step(state, inp):
        qi, ki, vi, gi = inp
        b = jnp.cumsum(gi, axis=2)
        b_last = b[:, :, -1:, :]
        o_inter = jnp.einsum('bhtk,bhkv->bhtv', qi * jnp.exp(b), state)
        diff = b[:, :, :, None, :] - b[:, :, None, :, :]
        decay = jnp.exp(jnp.where(causal[:, :, None], diff, -jnp.inf))
        scores = jnp.einsum('bhtk,bhtsk,bhsk->bhts', qi, decay, ki)
        o_intra = jnp.einsum('bhts,bhsv->bhtv', scores, vi)
        new_state = (jnp.exp(b_last[:, :, 0, :])[..., None] * state
                     + jnp.einsum('bhsk,bhsv->bhkv', ki * jnp.exp(b_last - b), vi))
        return new_state, o_inter + o_intra

    s0 = jnp.zeros((bsz, h, dk, dv), jnp.float32)
    _, o = lax.scan(step, s0, (to_chunks(q), to_chunks(k), to_chunks(v), to_chunks(log_f)))
    return o.transpose(1, 0, 3, 2, 4).reshape(bsz, s_len, h, dv)


def ssd_chunk_scan(x, dt, a, bm, cm):
    bsz, s_len, h, p = x.shape
    g, n = bm.shape[-2:]
    j = h // g
    nc = s_len // SSM_CHUNK
    l = SSM_CHUNK
    xc = (x * dt[..., None]).reshape(bsz, nc, l, g, j, p)
    da = (dt * a).reshape(bsz, nc, l, g, j).transpose(0, 3, 4, 1, 2)
    bc = bm.reshape(bsz, nc, l, g, n)
    cc = cm.reshape(bsz, nc, l, g, n)
    a_cs = jnp.cumsum(da, axis=-1)
    lmat = jnp.exp(segsum(da))
    cb = jnp.einsum('bclgn,bcsgn->bgcls', cc, bc)
    y_diag = jnp.einsum('bgjcls,bcsgjp->bclgjp', cb[:, :, None] * lmat, xc)
    decay_states = jnp.exp(a_cs[..., -1:] - a_cs).transpose(0, 3, 4, 1, 2)
    states = jnp.einsum('bclgn,bclgjp->bcgjpn', bc, xc * decay_states[..., None])
    chunk_decay = jnp.exp(segsum(jnp.pad(a_cs[..., -1], ((0, 0), (0, 0), (0, 0), (1, 0)))))
    states = jnp.concatenate([jnp.zeros_like(states[:, :1]), states], axis=1)
    states = jnp.einsum('bgjzc,bcgjpn->bzgjpn', chunk_decay, states)[:, :-1]
    state_decay_out = jnp.exp(a_cs).transpose(0, 3, 4, 1, 2)
    y_off = jnp.einsum('bclgn,bcgjpn->bclgjp', cc, states) * state_decay_out[..., None]
    return (y_diag + y_off).reshape(bsz, s_len, h, p)


def hgrn2_ssd_mixer(h, lb, w_in, hg_norm, conv_w, conv_b, dt_bias, a_log, d_skip, ssm_norm, w_out):
    bsz, s_len, _ = h.shape
    f32 = jnp.float32
    proj = jnp.einsum('bsd,de->bse', h, w_in)
    bounds = [sum(IN_SIZES[:m]) for m in range(1, len(IN_SIZES))]
    q, f_raw, i_val, g_out, z, xbc, dt_raw = jnp.split(proj, bounds, axis=-1)
    f = lb + (1.0 - lb) * jax.nn.sigmoid(f_raw.astype(f32))
    hg = lambda t: t.astype(f32).reshape(bsz, s_len, HG_HEADS, HG_DK)
    o_a = hgrn2_chunk_scan(hg(q), hg(1.0 - f), hg(i_val), hg(jnp.log(f)))
    o_a = group_rms_norm(o_a.reshape(bsz, s_len, HG_WIDTH), hg_norm, HG_HEADS) * jax.nn.silu(g_out.astype(f32))
    xbc = jax.nn.silu(causal_dwconv(xbc, conv_w, conv_b))
    xs, bm, cm = jnp.split(xbc, [SSM_WIDTH, SSM_WIDTH + SSM_GROUPS * SSM_STATE], axis=-1)
    dt = jax.nn.softplus(dt_raw.astype(f32) + dt_bias.astype(f32))
    a = -jnp.exp(a_log.astype(f32))
    xs_h = xs.astype(f32).reshape(bsz, s_len, SSM_HEADS, SSM_HEADDIM)
    y = ssd_chunk_scan(xs_h, dt, a,
                       bm.astype(f32).reshape(bsz, s_len, SSM_GROUPS, SSM_STATE),
                       cm.astype(f32).reshape(bsz, s_len, SSM_GROUPS, SSM_STATE))
    y = y + d_skip.astype(f32)[:, None] * xs_h
    o_b = group_rms_norm(y.reshape(bsz, s_len, SSM_WIDTH) * jax.nn.silu(z.astype(f32)), ssm_norm, SSM_GROUPS)
    o = jnp.concatenate([o_a, o_b], axis=-1).astype(h.dtype)
    return jnp.einsum('bse,ed->bsd', o, w_out).astype(h.dtype)


def rwkv7_scan(r, w, k, v, kk, a):
    def step(state, inp):
        r_t, w_t, k_t, v_t, kk_t, a_t = inp
        sa = jnp.einsum('bhvk,bhk->bhv', state, -kk_t)
        state = (state * w_t[:, :, None, :] + sa[..., None] * (kk_t * a_t)[:, :, None, :]
                 + v_t[..., None] * k_t[:, :, None, :])
        return state, jnp.einsum('bhvk,bhk->bhv', state, r_t)

    bsz, _, h, n = r.shape
    seq_first = tuple(t.transpose(1, 0, 2, 3) for t in (r, w, k, v, kk, a))
    s0 = jnp.zeros((bsz, h, n, n), jnp.float32)
    _, y = lax.scan(step, s0, seq_first)
    return y.transpose(1, 0, 2, 3)


def rwkv7_mixer(h, mu, w_rkv, w_dec0, w_dec1, w_dec2, a0, a1, a2, g1, g2, k_k, k_a, r_k, ln_w, ln_b, w_o):
    bsz, s_len, d = h.shape
    f32 = jnp.float32
    xx = jnp.pad(h[:, :-1], ((0, 0), (1, 0), (0, 0))) - h
    mixed = h[None] + xx[None] * mu[:, None, None, :]
    r, k, v = jnp.einsum('ibsd,ide->ibse', mixed[:3], w_rkv)
    xw, xa, xg = mixed[3], mixed[4], mixed[5]
    w_log = -jax.nn.softplus(-(w_dec0 + jnp.tanh(xw @ w_dec1) @ w_dec2).astype(f32)) - 0.5
    decay = jnp.exp(-jnp.exp(w_log))
    a = jax.nn.sigmoid((a0 + (xa @ a1) @ a2).astype(f32))
    g = jax.nn.sigmoid(xg @ g1) @ g2
    heads = lambda t: t.astype(f32).reshape(bsz, s_len, RW_HEADS, RW_HEADSIZE)
    r_h, v_h, w_h, a_h = heads(r), heads(v), heads(decay), heads(a)
    kk = heads(k * k_k)
    kk = kk / jnp.maximum(jnp.sqrt(jnp.sum(kk * kk, axis=-1, keepdims=True)), 1e-12)
    k_h = heads(k) * (1.0 + (a_h - 1.0) * k_a.astype(f32).reshape(RW_HEADS, RW_HEADSIZE))
    o = rwkv7_scan(r_h, w_h, k_h, v_h, kk, a_h)
    mean = jnp.mean(o, axis=-1, keepdims=True)
    var = jnp.mean(jnp.square(o - mean), axis=-1, keepdims=True)
    o = ((o - mean) * lax.rsqrt(var + RW_GN_EPS) * ln_w.astype(f32).reshape(RW_HEADS, RW_HEADSIZE)
         + ln_b.astype(f32).reshape(RW_HEADS, RW_HEADSIZE))
    o = o + jnp.sum(r_h * k_h * r_k.astype(f32), axis=-1, keepdims=True) * v_h
    o = (o.reshape(bsz, s_len, d) * g).astype(h.dtype)
    return (o @ w_o).astype(h.dtype)


def grouped_moe(h, router_w, router_b, w1, w3, w2):
    bsz, s_len, _ = h.shape
    logits = jnp.einsum('bsd,de->bse', h, router_w).astype(jnp.float32) + router_b.astype(jnp.float32)
    probs = jax.nn.softmax(logits, axis=-1)
    grouped = probs.reshape(bsz, s_len, N_EXPERT_GROUPS, EXPERTS_PER_GROUP)
    group_score = jnp.sum(lax.top_k(grouped, TOP_K)[0], axis=-1)
    group_mask = jax.nn.one_hot(jnp.argmax(group_score, axis=-1), N_EXPERT_GROUPS, dtype=bool)
    masked = jnp.where(group_mask[..., None], grouped, -1.0).reshape(bsz, s_len, N_EXPERTS)
    top_w, top_i = lax.top_k(masked, TOP_K)
    top_w = top_w / jnp.sum(top_w, axis=-1, keepdims=True)
    gates = jnp.sum(jax.nn.one_hot(top_i, N_EXPERTS, dtype=jnp.float32) * top_w[..., None], axis=-2)
    hidden = jax.nn.silu(jnp.einsum('bsd,edf->bsef', h, w1)) * jnp.einsum('bsd,edf->bsef', h, w3)
    hidden = hidden * gates.astype(hidden.dtype)[..., None]
    return jnp.einsum('bsef,efd->bsd', hidden, w2).astype(h.dtype)


def setup_inputs(seed: int = 0) -> dict:
    key = jax.random.key(seed)
    ks = iter(jax.random.split(key, 64))
    f32 = jnp.float32
    nrm = lambda shape, scale: jax.random.normal(next(ks), shape, f32) * scale
    uni = lambda shape, lo, hi: jax.random.uniform(next(ks), shape, f32, lo, hi)
    d = D_MODEL
    x = nrm((BATCH, SEQ, d), 1.0)
    c = nrm((BATCH, d), 1.0)
    mod_w = nrm((DEPTH, d, 6 * d), 0.5 * d ** -0.5)
    mod_b = nrm((DEPTH, 6 * d), 0.02)
    norm_w = 1.0 + nrm((DEPTH, 2, d), 0.02)
    hg_lb_logits = nrm((DEPTH + 1, HG_WIDTH), 1.0)
    ev_w_in = nrm((N_EVEN, d, IN_COLS), d ** -0.5)
    ev_hg_norm = 1.0 + nrm((N_EVEN, HG_WIDTH), 0.02)
    ev_conv_w = nrm((N_EVEN, SSM_CONV, SSM_XBC), SSM_CONV ** -0.5)
    ev_conv_b = nrm((N_EVEN, SSM_XBC), 0.02)
    dt0 = jnp.exp(uni((N_EVEN, SSM_HEADS), math.log(1e-3), math.log(1e-1)))
    ev_dt_bias = dt0 + jnp.log(-jnp.expm1(-dt0))
    ev_a_log = jnp.log(uni((N_EVEN, SSM_HEADS), 1.0, 16.0))
    ev_d_skip = 1.0 + nrm((N_EVEN, SSM_HEADS), 0.1)
    ev_ssm_norm = 1.0 + nrm((N_EVEN, SSM_WIDTH), 0.02)
    ev_w_out = nrm((N_EVEN, MIX_WIDTH, d), MIX_WIDTH ** -0.5)
    od_mu = uni((N_ODD, 6, d), 0.0, 1.0)
    od_w_rkv = nrm((N_ODD, 3, d, d), d ** -0.5)
    od_w_dec0 = uni((N_ODD, d), -6.0, 0.0)
    od_w_dec1 = nrm((N_ODD, d, RW_DECAY_LORA), d ** -0.5)
    od_w_dec2 = nrm((N_ODD, RW_DECAY_LORA, d), 0.5 * RW_DECAY_LORA ** -0.5)
    od_a0 = nrm((N_ODD, d), 0.5)
    od_a1 = nrm((N_ODD, d, RW_AAA_LORA), d ** -0.5)
    od_a2 = nrm((N_ODD, RW_AAA_LORA, d), 0.5 * RW_AAA_LORA ** -0.5)
    od_g1 = nrm((N_ODD, d, RW_GATE_LORA), d ** -0.5)
    od_g2 = nrm((N_ODD, RW_GATE_LORA, d), RW_GATE_LORA ** -0.5)
    od_k_k = 0.85 + nrm((N_ODD, d), 0.05)
    od_k_a = 1.0 + nrm((N_ODD, d), 0.05)
    od_r_k = nrm((N_ODD, RW_HEADS, RW_HEADSIZE), 0.1)
    od_ln_w = 1.0 + nrm((N_ODD, d), 0.02)
    od_ln_b = nrm((N_ODD, d), 0.02)
    od_w_o = nrm((N_ODD, d, d), d ** -0.5)
    router_w = nrm((d, N_EXPERTS), d ** -0.5)
    router_b = nrm((N_EXPERTS,), 0.01)
    moe_w1 = nrm((DEPTH, N_EXPERTS, d, D_EXPERT), d ** -0.5)
    moe_w3 = nrm((DEPTH, N_EXPERTS, d, D_EXPERT), d ** -0.5)
    moe_w2 = nrm((DEPTH, N_EXPERTS, D_EXPERT, d), D_EXPERT ** -0.5)
    final_norm_w = 1.0 + nrm((d,), 0.02)
    return {"x": x, "c": c, "mod_w": mod_w, "mod_b": mod_b, "norm_w": norm_w,
            "hg_lb_logits": hg_lb_logits, "ev_w_in": ev_w_in, "ev_hg_norm": ev_hg_norm,
            "ev_conv_w": ev_conv_w, "ev_conv_b": ev_conv_b, "ev_dt_bias": ev_dt_bias,
            "ev_a_log": ev_a_log, "ev_d_skip": ev_d_skip, "ev_ssm_norm": ev_ssm_norm,
            "ev_w_out": ev_w_out, "od_mu": od_mu, "od_w_rkv": od_w_rkv, "od_w_dec0": od_w_dec0,
            "od_w_dec1": od_w_dec1, "od_w_dec2": od_w_dec2, "od_a0": od_a0, "od_a1": od_a1,
            "od_a2": od_a2, "od_g1": od_g1, "od_g2": od_g2, "od_k_k": od_k_k, "od_k_a": od_k_a,
            "od_r_k": od_r_k, "od_ln_w": od_ln_w, "od_ln_b": od_ln_b, "od_w_o": od_w_o,
            "router_w": router_w, "router_b": router_b, "moe_w1": moe_w1, "moe_w3": moe_w3,
            "moe_w2": moe_w2, "final_norm_w": final_norm_w}


def reference(x, c, mod_w, mod_b, norm_w, hg_lb_logits, ev_w_in, ev_hg_norm, ev_conv_w, ev_conv_b,
              ev_dt_bias, ev_a_log, ev_d_skip, ev_ssm_norm, ev_w_out, od_mu, od_w_rkv, od_w_dec0,
              od_w_dec1, od_w_dec2, od_a0, od_a1, od_a2, od_g1, od_g2, od_k_k, od_k_a, od_r_k,
              od_ln_w, od_ln_b, od_w_o, router_w, router_b, moe_w1, moe_w3, moe_w2, final_norm_w):
    mod = jnp.einsum('bd,lde->lbe', jax.nn.silu(c), mod_w) + mod_b[:, None, :]
    gamma = jax.nn.softmax(hg_lb_logits.astype(jnp.float32), axis=0)
    lower_bounds = jnp.cumsum(gamma, axis=0) - gamma[0]
    for l in range(DEPTH):
        sh_m, sc_m, gt_m, sh_f, sc_f, gt_f = jnp.split(mod[l], 6, axis=-1)
        h = modulate(rms_norm(x, norm_w[l, 0]), sh_m, sc_m)
        j = l // 2
        if l % 2 == 0:
            y = hgrn2_ssd_mixer(h, lower_bounds[l + 1], ev_w_in[j], ev_hg_norm[j], ev_conv_w[j],
                                ev_conv_b[j], ev_dt_bias[j], ev_a_log[j], ev_d_skip[j],
                                ev_ssm_norm[j], ev_w_out[j])
        else:
            y = rwkv7_mixer(h, od_mu[j], od_w_rkv[j], od_w_dec0[j], od_w_dec1[j], od_w_dec2[j],
                            od_a0[j], od_a1[j], od_a2[j], od_g1[j], od_g2[j], od_k_k[j], od_k_a[j],
                            od_r_k[j], od_ln_w[j], od_ln_b[j], od_w_o[j])
        x = x + gt_m[:, None, :] * y
        h = modulate(rms_norm(x, norm_w[l, 1]), sh_f, sc_f)
        x = x + gt_f[:, None, :] * grouped_moe(h, router_w, router_b, moe_w1[l], moe_w3[l], moe_w2[l])
    return rms_norm(x, final_norm_w)
```

```cpp
#include <hip/hip_runtime.h>
#include <hip/hip_cooperative_groups.h>
#include <stdint.h>
#include <stdio.h>

typedef unsigned short bf16_t;
typedef __attribute__((ext_vector_type(8))) short bf16x8;
typedef __attribute__((ext_vector_type(4))) short bf16x4;
typedef __attribute__((ext_vector_type(4))) float f32x4;

constexpr int T = 16384;
constexpr int SEQ = 4096;
constexpr int NPROJ = 6656;

constexpr size_t MiB = 1048576;
constexpr size_t OFF_MOD = 0;
constexpr size_t OFF_LB = 196608;
constexpr size_t OFF_CNT = 200704;
constexpr size_t OFF_DT = 200960;
constexpr size_t OFF_GATES = OFF_DT + (size_t)T * 16 * 4;
constexpr size_t OFF_BONUS = OFF_GATES + (size_t)T * 2 * 4;
constexpr size_t OFF_LIST = OFF_BONUS + (size_t)T * 16 * 4;
constexpr size_t OFF_WA = 8 * MiB;
constexpr size_t OFF_S1 = 28 * MiB;
constexpr size_t OFF_S2 = 60 * MiB;
constexpr size_t OFF_BIG = 124 * MiB;
constexpr size_t WS_NEED = 340 * MiB;
constexpr size_t OFF_WINT = OFF_WA;
constexpr size_t OFF_WOUTT = OFF_WA + 13 * MiB;
constexpr size_t OFF_WRKVT = OFF_WA;
constexpr size_t OFF_WOT = OFF_WA + 6 * MiB;
constexpr size_t OFF_LORA1T = OFF_WA + 8 * MiB;
constexpr size_t OFF_DEC2T = OFF_WA + 9 * MiB;
constexpr size_t OFF_A2T = OFF_DEC2T + 131072;
constexpr size_t OFF_G2T = OFF_A2T + 131072;
constexpr size_t OFF_PROJ = OFF_BIG;
constexpr size_t OFF_W13T = OFF_BIG;
constexpr size_t OFF_W2T = OFF_BIG + 32 * MiB;
constexpr size_t OFF_HID = OFF_BIG + 48 * MiB;
constexpr size_t OFF_R = OFF_BIG;
constexpr size_t OFF_K = OFF_BIG + 32 * MiB;
constexpr size_t OFF_V = OFF_BIG + 64 * MiB;
constexpr size_t OFF_KK = OFF_BIG + 96 * MiB;
constexpr size_t OFF_AA = OFF_BIG + 128 * MiB;
constexpr size_t OFF_G = OFF_BIG + 160 * MiB;
constexpr size_t OFF_LORA1 = OFF_BIG + 192 * MiB;

struct P {
  const float *x, *c, *mod_w, *mod_b, *norm_w, *lb_logits, *w_in, *hg_norm, *conv_w, *conv_b, *dt_bias, *a_log,
      *d_skip, *ssm_norm, *w_out, *mu, *w_rkv, *dec0, *dec1, *dec2, *a0, *a1, *a2, *g1, *g2, *k_k, *k_a, *r_k,
      *ln_w, *ln_b, *w_o, *router_w, *router_b, *moe_w1, *moe_w3, *moe_w2, *final_w;
  float* out;
  char* ws;
};

__device__ __forceinline__ float bf2f(bf16_t h) { return __uint_as_float(((uint32_t)h) << 16); }
__device__ __forceinline__ float bfs2f(short h) { return __uint_as_float(((uint32_t)(unsigned short)h) << 16); }
__device__ __forceinline__ bf16_t f2bf(float f) {
  uint32_t u = __float_as_uint(f);
  u += 0x7fffu + ((u >> 16) & 1u);
  return (bf16_t)(u >> 16);
}
__device__ __forceinline__ float sigmoidf_(float x) { return 1.f / (1.f + __expf(-x)); }
__device__ __forceinline__ float siluf_(float x) { return x / (1.f + __expf(-x)); }
__device__ __forceinline__ float softplusf_(float x) { return x > 20.f ? x : log1pf(__expf(x)); }
__device__ __forceinline__ float wave_sum(float v) {
#pragma unroll
  for (int m = 32; m >= 1; m >>= 1) v += __shfl_xor(v, m, 64);
  return v;
}
__device__ __forceinline__ uint2 pack4(float a, float b, float c, float d) {
  uint2 r;
  r.x = (uint32_t)f2bf(a) | ((uint32_t)f2bf(b) << 16);
  r.y = (uint32_t)f2bf(c) | ((uint32_t)f2bf(d) << 16);
  return r;
}

constexpr int LSTR = 144;
constexpr int SMEM_BYTES = 2 * 128 * LSTR;

template <class AF, class BF, class EF>
__device__ __forceinline__ void gemm_tile(AF af, BF bf, int nk, EF ef, char* smem) {
  const int tid = threadIdx.x, lane = tid & 63, wid = tid >> 6, wr = wid >> 1, wc = wid & 1, fr = lane & 15,
            fq = lane >> 4;
  char* sA = smem;
  char* sB = smem + 128 * LSTR;
  const int lrow = tid >> 3, lkc = tid & 7;
  bf16x8 ra[4], rb[4];
  f32x4 acc[4][4];
#pragma unroll
  for (int m = 0; m < 4; ++m)
#pragma unroll
    for (int n = 0; n < 4; ++n) acc[m][n] = (f32x4){0.f, 0.f, 0.f, 0.f};
#pragma unroll
  for (int i = 0; i < 4; ++i) {
    ra[i] = af(i, lrow + 32 * i, lkc * 8);
    rb[i] = bf(i, lrow + 32 * i, lkc * 8);
  }
  for (int kt = 0; kt < nk; ++kt) {
    __syncthreads();
#pragma unroll
    for (int i = 0; i < 4; ++i) {
      *(bf16x8*)(sA + (lrow + 32 * i) * LSTR + lkc * 16) = ra[i];
      *(bf16x8*)(sB + (lrow + 32 * i) * LSTR + lkc * 16) = rb[i];
    }
    __syncthreads();
    if (kt + 1 < nk) {
#pragma unroll
      for (int i = 0; i < 4; ++i) {
        ra[i] = af(i, lrow + 32 * i, (kt + 1) * 64 + lkc * 8);
        rb[i] = bf(i, lrow + 32 * i, (kt + 1) * 64 + lkc * 8);
      }
    }
#pragma unroll
    for (int s = 0; s < 2; ++s) {
      bf16x8 a[4], b[4];
#pragma unroll
      for (int m = 0; m < 4; ++m) a[m] = *(const bf16x8*)(sA + (wr * 64 + m * 16 + fr) * LSTR + s * 64 + fq * 16);
#pragma unroll
      for (int n = 0; n < 4; ++n) b[n] = *(const bf16x8*)(sB + (wc * 64 + n * 16 + fr) * LSTR + s * 64 + fq * 16);
#pragma unroll
      for (int m = 0; m < 4; ++m)
#pragma unroll
        for (int n = 0; n < 4; ++n) acc[m][n] = __builtin_amdgcn_mfma_f32_16x16x32_bf16(a[m], b[n], acc[m][n], 0, 0, 0);
    }
  }
  ef(acc, wr * 64 + fq * 4, wc * 64 + fr);
}

__device__ __forceinline__ void ph_prep(const P& p, int bid, int nb, char* smem) {
  float* sc = (float*)smem;
  float* red = sc + 4096;
  const int tid = threadIdx.x;
  float* mod = (float*)(p.ws + OFF_MOD);
  for (int i = tid; i < 4096; i += 256) sc[i] = siluf_(p.c[i]);
  __syncthreads();
  for (int u = bid; u < 192; u += nb) {
    int l = u / 96, e0 = (u % 96) * 64;
    int kq = tid >> 6, col = tid & 63;
    const float* w = p.mod_w + ((size_t)l * 1024 + kq * 256) * 6144 + e0 + col;
    float a0 = 0, a1 = 0, a2 = 0, a3 = 0;
    for (int d = 0; d < 256; ++d) {
      float wv = w[(size_t)d * 6144];
      int dd = kq * 256 + d;
      a0 += sc[dd] * wv;
      a1 += sc[1024 + dd] * wv;
      a2 += sc[2048 + dd] * wv;
      a3 += sc[3072 + dd] * wv;
    }
    red[(kq * 64 + col) * 4 + 0] = a0;
    red[(kq * 64 + col) * 4 + 1] = a1;
    red[(kq * 64 + col) * 4 + 2] = a2;
    red[(kq * 64 + col) * 4 + 3] = a3;
    __syncthreads();
    {
      int b = tid >> 6, c2 = tid & 63;
      float s = 0;
      for (int q = 0; q < 4; ++q) s += red[(q * 64 + c2) * 4 + b];
      mod[(l * 4 + b) * 6144 + e0 + c2] = s + p.mod_b[l * 6144 + e0 + c2];
    }
    __syncthreads();
  }
  if (bid == 0) {
    float* lb = (float*)(p.ws + OFF_LB);
    for (int ch = tid; ch < 1024; ch += 256) {
      float l0 = p.lb_logits[ch], l1 = p.lb_logits[1024 + ch], l2 = p.lb_logits[2048 + ch];
      float m = fmaxf(l0, fmaxf(l1, l2));
      float e0 = __expf(l0 - m), e1 = __expf(l1 - m), e2 = __expf(l2 - m);
      lb[ch] = e1 / (e0 + e1 + e2);
    }
    int* cnt = (int*)(p.ws + OFF_CNT);
    if (tid < 64) cnt[tid] = 0;
  }
}

template <int MODE>
__device__ __forceinline__ int rowmap(int n) {
  if (MODE == 0) return n;
  int nt8 = n >> 6, wc = (n >> 5) & 1, np = (n >> 4) & 1, fr = n & 15;
  return nt8 * 128 + wc * 64 + (2 * np + (MODE - 1)) * 16 + fr;
}
template <int MODE>
__device__ __forceinline__ void conv_mat(const float* src, int lds_, int K, int N, bf16_t* dst, int ldd, int dk0, const float* scale,
                         int bid, int nb, char* smem) {
  float* tile = (float*)smem;
  const int tid = threadIdx.x;
  const int tn = N >> 6, ntile = (K >> 6) * tn;
  for (int t = bid; t < ntile; t += nb) {
    int k0 = (t / tn) * 64, n0 = (t % tn) * 64;
    __syncthreads();
#pragma unroll
    for (int i = 0; i < 16; ++i) {
      int idx = tid + i * 256, r = idx >> 6, cc = idx & 63;
      float v = src[(size_t)(k0 + r) * lds_ + n0 + cc];
      if (scale) v *= scale[k0 + r];
      tile[r * 65 + cc] = v;
    }
    __syncthreads();
#pragma unroll
    for (int i = 0; i < 2; ++i) {
      int idx = tid + i * 256, n = idx >> 3, kc = idx & 7;
      bf16x8 o;
#pragma unroll
      for (int j = 0; j < 8; ++j) o[j] = (short)f2bf(tile[(kc * 8 + j) * 65 + n]);
      *(bf16x8*)(dst + (size_t)rowmap<MODE>(n0 + n) * ldd + dk0 + k0 + kc * 8) = o;
    }
  }
  __syncthreads();
}
__device__ __forceinline__ void ph_conv_w0(const P& p, int bid, int nb, char* smem) {
  conv_mat<0>(p.w_in, 6672, 1024, NPROJ, (bf16_t*)(p.ws + OFF_WINT), 1024, 0, nullptr, bid, nb, smem);
  conv_mat<0>(p.w_out, 1024, 2048, 1024, (bf16_t*)(p.ws + OFF_WOUTT), 2048, 0, nullptr, bid, nb, smem);
}
__device__ __forceinline__ void ph_conv_w1(const P& p, int bid, int nb, char* smem) {
  for (int i = 0; i < 3; ++i)
    conv_mat<0>(p.w_rkv + (size_t)i * 1048576, 1024, 1024, 1024, (bf16_t*)(p.ws + OFF_WRKVT) + (size_t)i * 1048576,
                1024, 0, nullptr, bid, nb, smem);
  conv_mat<0>(p.w_o, 1024, 1024, 1024, (bf16_t*)(p.ws + OFF_WOT), 1024, 0, nullptr, bid, nb, smem);
  bf16_t* l1 = (bf16_t*)(p.ws + OFF_LORA1T);
  conv_mat<0>(p.dec1, 64, 1024, 64, l1, 2048, 0, nullptr, bid, nb, smem);
  conv_mat<0>(p.dec1, 64, 1024, 64, l1, 2048, 1024, p.mu + 3 * 1024, bid, nb, smem);
  conv_mat<0>(p.a1, 64, 1024, 64, l1 + 64 * 2048, 2048, 0, nullptr, bid, nb, smem);
  conv_mat<0>(p.a1, 64, 1024, 64, l1 + 64 * 2048, 2048, 1024, p.mu + 4 * 1024, bid, nb, smem);
  conv_mat<0>(p.g1, 128, 1024, 128, l1 + 128 * 2048, 2048, 0, nullptr, bid, nb, smem);
  conv_mat<0>(p.g1, 128, 1024, 128, l1 + 128 * 2048, 2048, 1024, p.mu + 5 * 1024, bid, nb, smem);
  conv_mat<0>(p.dec2, 1024, 64, 1024, (bf16_t*)(p.ws + OFF_DEC2T), 64, 0, nullptr, bid, nb, smem);
  conv_mat<0>(p.a2, 1024, 64, 1024, (bf16_t*)(p.ws + OFF_A2T), 64, 0, nullptr, bid, nb, smem);
  conv_mat<0>(p.g2, 1024, 128, 1024, (bf16_t*)(p.ws + OFF_G2T), 128, 0, nullptr, bid, nb, smem);
}
__device__ __forceinline__ void ph_conv_moe(const P& p, int layer, int bid, int nb, char* smem) {
  for (int e = 0; e < 16; ++e) {
    size_t so = ((size_t)layer * 16 + e) * 524288;
    bf16_t* d13 = (bf16_t*)(p.ws + OFF_W13T) + (size_t)e * 1048576;
    conv_mat<1>(p.moe_w1 + so, 512, 1024, 512, d13, 1024, 0, nullptr, bid, nb, smem);
    conv_mat<2>(p.moe_w3 + so, 512, 1024, 512, d13, 1024, 0, nullptr, bid, nb, smem);
    conv_mat<0>(p.moe_w2 + so, 1024, 512, 1024, (bf16_t*)(p.ws + OFF_W2T) + (size_t)e * 524288, 512, 0, nullptr, bid,
                nb, smem);
  }
}

__device__ __forceinline__ void row_norm_mod(const float* xrow, const float* nw, const float* sh, const float* sc,
                                             int lane, float (&h)[16]) {
  const float4* xr = (const float4*)xrow;
  float4 v[4];
  float ss = 0;
#pragma unroll
  for (int i = 0; i < 4; ++i) {
    v[i] = xr[lane + 64 * i];
    ss += v[i].x * v[i].x + v[i].y * v[i].y + v[i].z * v[i].z + v[i].w * v[i].w;
  }
  ss = wave_sum(ss);
  float rstd = rsqrtf(ss * (1.f / 1024.f) + 1e-6f);
#pragma unroll
  for (int i = 0; i < 4; ++i) {
    int d0 = (lane + 64 * i) * 4;
    float4 w4 = *(const float4*)(nw + d0), s4 = *(const float4*)(sh + d0), c4 = *(const float4*)(sc + d0);
    h[i * 4 + 0] = v[i].x * rstd * w4.x * (1.f + c4.x) + s4.x;
    h[i * 4 + 1] = v[i].y * rstd * w4.y * (1.f + c4.y) + s4.y;
    h[i * 4 + 2] = v[i].z * rstd * w4.z * (1.f + c4.z) + s4.z;
    h[i * 4 + 3] = v[i].w * rstd * w4.w * (1.f + c4.w) + s4.w;
  }
}
__device__ __forceinline__ void store_hbf(bf16_t* hrow, int lane, const float (&h)[16]) {
#pragma unroll
  for (int i = 0; i < 4; ++i) {
    int d0 = (lane + 64 * i) * 4;
    *(uint2*)(hrow + d0) = pack4(h[i * 4], h[i * 4 + 1], h[i * 4 + 2], h[i * 4 + 3]);
  }
}

__device__ __forceinline__ void ph_norm0(const P& p, int bid, int nb) {
  const int lane = threadIdx.x & 63, wid = threadIdx.x >> 6;
  const float* mod = (const float*)(p.ws + OFF_MOD);
  bf16_t* hbf = (bf16_t*)(p.ws + OFF_S1);
  float* dt = (float*)(p.ws + OFF_DT);
  for (int t = bid * 4 + wid; t < T; t += nb * 4) {
    int b = t >> 12;
    const float* m0 = mod + (size_t)(0 * 4 + b) * 6144;
    float h[16];
    row_norm_mod(p.x + (size_t)t * 1024, p.norm_w + 0, m0, m0 + 1024, lane, h);
    store_hbf(hbf + (size_t)t * 1024, lane, h);
    float da[16];
#pragma unroll
    for (int j = 0; j < 16; ++j) da[j] = 0.f;
#pragma unroll
    for (int i = 0; i < 4; ++i) {
#pragma unroll
      for (int j = 0; j < 4; ++j) {
        int d = (lane + 64 * i) * 4 + j;
        const float4* wd = (const float4*)(p.w_in + (size_t)d * 6672 + NPROJ);
        float hv = h[i * 4 + j];
#pragma unroll
        for (int q = 0; q < 4; ++q) {
          float4 w4 = wd[q];
          da[q * 4 + 0] += hv * w4.x;
          da[q * 4 + 1] += hv * w4.y;
          da[q * 4 + 2] += hv * w4.z;
          da[q * 4 + 3] += hv * w4.w;
        }
      }
    }
    float val = 0.f;
#pragma unroll
    for (int j = 0; j < 16; ++j) {
      float s = wave_sum(da[j]);
      if (lane == j) val = s;
    }
    if (lane < 16) dt[(size_t)t * 16 + lane] = softplusf_(val + p.dt_bias[lane]);
  }
}

__device__ __forceinline__ void ph_gemm_inproj(const P& p, int bid, int nb, char* smem) {
  const bf16_t* A = (const bf16_t*)(p.ws + OFF_S1);
  const bf16_t* B = (const bf16_t*)(p.ws + OFF_WINT);
  bf16_t* C = (bf16_t*)(p.ws + OFF_PROJ);
  const int MT = 128, NT = 52;
  for (int w = bid; w < MT * NT; w += nb) {
    int mt = w % MT, nt = w / MT;
    const bf16_t* Ab = A + (size_t)mt * 128 * 1024;
    const bf16_t* Bb = B + (size_t)nt * 128 * 1024;
    bf16_t* Cb = C + (size_t)mt * 128 * NPROJ + nt * 128;
    gemm_tile([&](int i, int r, int k) { return *(const bf16x8*)(Ab + (size_t)r * 1024 + k); },
              [&](int i, int r, int k) { return *(const bf16x8*)(Bb + (size_t)r * 1024 + k); }, 16,
              [&](f32x4(&acc)[4][4], int r0, int c0) {
#pragma unroll
                for (int m = 0; m < 4; ++m)
#pragma unroll
                  for (int n = 0; n < 4; ++n)
#pragma unroll
                    for (int j = 0; j < 4; ++j)
                      Cb[(size_t)(r0 + m * 16 + j) * NPROJ + c0 + n * 16] = f2bf(acc[m][n][j]);
              },
              smem);
  }
}

template <bool FIRST>
__device__ __forceinline__ void ph_gemm_resid(const P& p, const bf16_t* A, int lda, const bf16_t* B, int K, const float* gate,
                              int bid, int nb, char* smem) {
  for (int w = bid; w < 128 * 8; w += nb) {
    int mt = w % 128, nt = w / 128;
    const bf16_t* Ab = A + (size_t)mt * 128 * lda;
    const bf16_t* Bb = B + (size_t)nt * 128 * K;
    const float* gt = gate + (size_t)(mt >> 5) * 6144 + nt * 128;
    gemm_tile([&](int i, int r, int k) { return *(const bf16x8*)(Ab + (size_t)r * lda + k); },
              [&](int i, int r, int k) { return *(const bf16x8*)(Bb + (size_t)r * K + k); }, K / 64,
              [&](f32x4(&acc)[4][4], int r0, int c0) {
#pragma unroll
                for (int m = 0; m < 4; ++m)
#pragma unroll
                  for (int n = 0; n < 4; ++n)
#pragma unroll
                    for (int j = 0; j < 4; ++j) {
                      size_t idx = (size_t)(mt * 128 + r0 + m * 16 + j) * 1024 + nt * 128 + c0 + n * 16;
                      float base = FIRST ? p.x[idx] : p.out[idx];
                      p.out[idx] = base + gt[c0 + n * 16] * acc[m][n][j];
                    }
              },
              smem);
  }
}

__device__ __forceinline__ void ph_conv(const P& p, int bid, int nb) {
  const bf16_t* proj = (const bf16_t*)(p.ws + OFF_PROJ);
  bf16_t* xc = (bf16_t*)p.out;
  for (int idx = bid * 256 + threadIdx.x; idx < T * 192; idx += nb * 256) {
    int t = idx / 192, c0 = (idx % 192) * 8, tl = t & (SEQ - 1);
    float acc[8];
#pragma unroll
    for (int j = 0; j < 8; ++j) acc[j] = p.conv_b[c0 + j];
#pragma unroll
    for (int jj = 0; jj < 4; ++jj) {
      if (tl - 3 + jj >= 0) {
        bf16x8 v = *(const bf16x8*)(proj + (size_t)(t - 3 + jj) * NPROJ + 5120 + c0);
#pragma unroll
        for (int j = 0; j < 8; ++j) acc[j] += p.conv_w[jj * 1536 + c0 + j] * bfs2f(v[j]);
      }
    }
    bf16x8 o;
#pragma unroll
    for (int j = 0; j < 8; ++j) o[j] = (short)f2bf(siluf_(acc[j]));
    *(bf16x8*)(xc + (size_t)t * 1536 + c0) = o;
  }
}

__device__ __forceinline__ void ph_scan0(const P& p, int bid, int nb, char* smem) {
  const bf16_t* proj = (const bf16_t*)(p.ws + OFF_PROJ);
  const bf16_t* xc = (const bf16_t*)p.out;
  bf16_t* o = (bf16_t*)(p.ws + OFF_S2);
  const float* lb = (const float*)(p.ws + OFF_LB);
  const float* dt = (const float*)(p.ws + OFF_DT);
  const int tid = threadIdx.x;
  for (int u = bid; u < 96; u += nb) {
    if (u < 32) {
      const int b = u >> 3, h = u & 7;
      float* qs = (float*)smem;
      float* fs = qs + 2048;
      float* vs = fs + 2048;
      const int v = tid >> 1, half = tid & 1;
      float S[64];
#pragma unroll
      for (int k = 0; k < 64; ++k) S[k] = 0.f;
      const int st_l = tid >> 4, k0_l = (tid & 15) * 8;
      float lbv[8];
#pragma unroll
      for (int j = 0; j < 8; ++j) lbv[j] = lb[h * 128 + k0_l + j];
      for (int t0 = 0; t0 < SEQ; t0 += 16) {
        __syncthreads();
        {
          const bf16_t* row = proj + (size_t)(b * SEQ + t0 + st_l) * NPROJ + h * 128 + k0_l;
          bf16x8 q8 = *(const bf16x8*)row, f8 = *(const bf16x8*)(row + 1024), i8 = *(const bf16x8*)(row + 2048);
#pragma unroll
          for (int j = 0; j < 8; ++j) {
            qs[st_l * 128 + k0_l + j] = bfs2f(q8[j]);
            fs[st_l * 128 + k0_l + j] = lbv[j] + (1.f - lbv[j]) * sigmoidf_(bfs2f(f8[j]));
            vs[st_l * 128 + k0_l + j] = bfs2f(i8[j]);
          }
        }
        __syncthreads();
        for (int st = 0; st < 16; ++st) {
          float vv = vs[st * 128 + v];
          float oo = 0.f;
          const float4* f4 = (const float4*)(fs + st * 128 + half * 64);
          const float4* q4 = (const float4*)(qs + st * 128 + half * 64);
#pragma unroll
          for (int kq = 0; kq < 16; ++kq) {
            float4 f = f4[kq], q = q4[kq];
            S[kq * 4 + 0] = f.x * S[kq * 4 + 0] + (1.f - f.x) * vv;
            oo += S[kq * 4 + 0] * q.x;
            S[kq * 4 + 1] = f.y * S[kq * 4 + 1] + (1.f - f.y) * vv;
            oo += S[kq * 4 + 1] * q.y;
            S[kq * 4 + 2] = f.z * S[kq * 4 + 2] + (1.f - f.z) * vv;
            oo += S[kq * 4 + 2] * q.z;
            S[kq * 4 + 3] = f.w * S[kq * 4 + 3] + (1.f - f.w) * vv;
            oo += S[kq * 4 + 3] * q.w;
          }
          oo += __shfl_xor(oo, 1, 64);
          if (half == 0) o[(size_t)(b * SEQ + t0 + st) * 2048 + h * 128 + v] = f2bf(oo);
        }
      }
    } else {
      const int uu = u - 32, b = uu >> 4, hd = uu & 15, g = hd >> 3;
      float* Bs = (float*)smem;
      float* Cs = Bs + 2048;
      float* xs = Cs + 2048;
      float* zs = xs + 1024;
      float* dts = zs + 1024;
      const int pp = tid >> 2, qd = tid & 3;
      float hh[32];
#pragma unroll
      for (int n = 0; n < 32; ++n) hh[n] = 0.f;
      const float a = -__expf(p.a_log[hd]);
      const float dsk = p.d_skip[hd];
      const int st_l = tid >> 4, n0_l = (tid & 15) * 8;
      for (int t0 = 0; t0 < SEQ; t0 += 16) {
        __syncthreads();
        {
          const size_t tt = (size_t)(b * SEQ + t0 + st_l);
          bf16x8 b8 = *(const bf16x8*)(xc + tt * 1536 + 1024 + g * 128 + n0_l);
          bf16x8 c8 = *(const bf16x8*)(xc + tt * 1536 + 1280 + g * 128 + n0_l);
#pragma unroll
          for (int j = 0; j < 8; ++j) {
            Bs[st_l * 128 + n0_l + j] = bfs2f(b8[j]);
            Cs[st_l * 128 + n0_l + j] = bfs2f(c8[j]);
          }
          if (tid < 128) {
            int st2 = tid >> 3, p0 = (tid & 7) * 8;
            const size_t t2 = (size_t)(b * SEQ + t0 + st2);
            bf16x8 x8 = *(const bf16x8*)(xc + t2 * 1536 + hd * 64 + p0);
            bf16x8 z8 = *(const bf16x8*)(proj + t2 * NPROJ + 4096 + hd * 64 + p0);
#pragma unroll
            for (int j = 0; j < 8; ++j) {
              xs[st2 * 64 + p0 + j] = bfs2f(x8[j]);
              zs[st2 * 64 + p0 + j] = bfs2f(z8[j]);
            }
          }
          if (tid < 16) dts[tid] = dt[(size_t)(b * SEQ + t0 + tid) * 16 + hd];
        }
        __syncthreads();
        for (int st = 0; st < 16; ++st) {
          float dtt = dts[st];
          float dA = __expf(dtt * a);
          float xv = xs[st * 64 + pp];
          float coef = dtt * xv;
          float y = 0.f;
          const float4* B4 = (const float4*)(Bs + st * 128 + qd * 32);
          const float4* C4 = (const float4*)(Cs + st * 128 + qd * 32);
#pragma unroll
          for (int nq = 0; nq < 8; ++nq) {
            float4 bb = B4[nq], cc = C4[nq];
            hh[nq * 4 + 0] = dA * hh[nq * 4 + 0] + coef * bb.x;
            y += cc.x * hh[nq * 4 + 0];
            hh[nq * 4 + 1] = dA * hh[nq * 4 + 1] + coef * bb.y;
            y += cc.y * hh[nq * 4 + 1];
            hh[nq * 4 + 2] = dA * hh[nq * 4 + 2] + coef * bb.z;
            y += cc.z * hh[nq * 4 + 2];
            hh[nq * 4 + 3] = dA * hh[nq * 4 + 3] + coef * bb.w;
            y += cc.w * hh[nq * 4 + 3];
          }
          y += __shfl_xor(y, 1, 64);
          y += __shfl_xor(y, 2, 64);
          if (qd == 0) {
            y += dsk * xv;
            o[(size_t)(b * SEQ + t0 + st) * 2048 + 1024 + hd * 64 + pp] = f2bf(y * siluf_(zs[st * 64 + pp]));
          }
        }
      }
    }
  }
}

__device__ __forceinline__ void ph_norms0(const P& p, int bid, int nb) {
  const int lane = threadIdx.x & 63, wid = threadIdx.x >> 6;
  bf16_t* o = (bf16_t*)(p.ws + OFF_S2);
  const bf16_t* proj = (const bf16_t*)(p.ws + OFF_PROJ);
  for (int t = bid * 4 + wid; t < T; t += nb * 4) {
    bf16_t* row = o + (size_t)t * 2048 + lane * 32;
    float v[32];
    float ss = 0.f;
#pragma unroll
    for (int i = 0; i < 4; ++i) {
      bf16x8 x8 = *(const bf16x8*)(row + i * 8);
#pragma unroll
      for (int j = 0; j < 8; ++j) {
        v[i * 8 + j] = bfs2f(x8[j]);
        ss += v[i * 8 + j] * v[i * 8 + j];
      }
    }
    ss += __shfl_xor(ss, 1, 64);
    ss += __shfl_xor(ss, 2, 64);
    float s16 = ss;
    s16 += __shfl_xor(s16, 4, 64);
    s16 += __shfl_xor(s16, 8, 64);
    const bool isA = lane < 32;
    float rstd = isA ? rsqrtf(ss * (1.f / 128.f) + 1e-6f) : rsqrtf(s16 * (1.f / 512.f) + 1e-6f);
    const int c0 = isA ? lane * 32 : lane * 32 - 1024;
    const float* nw = isA ? p.hg_norm + c0 : p.ssm_norm + c0;
    const bf16_t* grow = proj + (size_t)t * NPROJ + 3072 + (isA ? c0 : 0);
#pragma unroll
    for (int i = 0; i < 4; ++i) {
      bf16x8 g8 = *(const bf16x8*)(grow + i * 8);
      bf16x8 o8;
#pragma unroll
      for (int j = 0; j < 8; ++j) {
        float val = v[i * 8 + j] * rstd * nw[i * 8 + j];
        if (isA) val *= siluf_(bfs2f(g8[j]));
        o8[j] = (short)f2bf(val);
      }
      *(bf16x8*)(row + i * 8) = o8;
    }
  }
}

__device__ __forceinline__ void ph_route(const P& p, int layer, int bid, int nb) {
  const int lane = threadIdx.x & 63, wid = threadIdx.x >> 6;
  const float* mod = (const float*)(p.ws + OFF_MOD);
  bf16_t* hbf = (bf16_t*)(p.ws + OFF_S1);
  int* cnt = (int*)(p.ws + OFF_CNT) + layer * 32;
  int* list = (int*)(p.ws + OFF_LIST);
  float* gates = (float*)(p.ws + OFF_GATES);
  for (int t = bid * 4 + wid; t < T; t += nb * 4) {
    int b = t >> 12;
    const float* m0 = mod + (size_t)(layer * 4 + b) * 6144;
    float h[16];
    row_norm_mod(p.out + (size_t)t * 1024, p.norm_w + (layer * 2 + 1) * 1024, m0 + 3072, m0 + 4096, lane, h);
    store_hbf(hbf + (size_t)t * 1024, lane, h);
    float lg[16];
#pragma unroll
    for (int j = 0; j < 16; ++j) lg[j] = 0.f;
#pragma unroll
    for (int i = 0; i < 4; ++i) {
#pragma unroll
      for (int j = 0; j < 4; ++j) {
        int d = (lane + 64 * i) * 4 + j;
        const float4* wd = (const float4*)(p.router_w + (size_t)d * 16);
        float hv = h[i * 4 + j];
#pragma unroll
        for (int q = 0; q < 4; ++q) {
          float4 w4 = wd[q];
          lg[q * 4 + 0] += hv * w4.x;
          lg[q * 4 + 1] += hv * w4.y;
          lg[q * 4 + 2] += hv * w4.z;
          lg[q * 4 + 3] += hv * w4.w;
        }
      }
    }
    float mx = -1e30f;
#pragma unroll
    for (int j = 0; j < 16; ++j) {
      lg[j] = wave_sum(lg[j]) + p.router_b[j];
      mx = fmaxf(mx, lg[j]);
    }
    float sum = 0.f;
#pragma unroll
    for (int j = 0; j < 16; ++j) {
      lg[j] = __expf(lg[j] - mx);
      sum += lg[j];
    }
    float inv = 1.f / sum;
#pragma unroll
    for (int j = 0; j < 16; ++j) lg[j] *= inv;
    int best = 0;
    float bests = -1.f;
    float q0 = 0, q1 = 0, q2 = 0, q3 = 0;
#pragma unroll
    for (int g = 0; g < 4; ++g) {
      float a0 = lg[g * 4], a1 = lg[g * 4 + 1], a2 = lg[g * 4 + 2], a3 = lg[g * 4 + 3];
      float hi01 = fmaxf(a0, a1), lo01 = fminf(a0, a1), hi23 = fmaxf(a2, a3), lo23 = fminf(a2, a3);
      float m1 = fmaxf(hi01, hi23);
      float m2 = fmaxf(fminf(hi01, hi23), fmaxf(lo01, lo23));
      float s = m1 + m2;
      if (s > bests) {
        bests = s;
        best = g;
        q0 = a0;
        q1 = a1;
        q2 = a2;
        q3 = a3;
      }
    }
    int i1 = 0;
    float v1 = q0;
    if (q1 > v1) { v1 = q1; i1 = 1; }
    if (q2 > v1) { v1 = q2; i1 = 2; }
    if (q3 > v1) { v1 = q3; i1 = 3; }
    int i2 = -1;
    float v2 = -1.f;
    if (i1 != 0 && q0 > v2) { v2 = q0; i2 = 0; }
    if (i1 != 1 && q1 > v2) { v2 = q1; i2 = 1; }
    if (i1 != 2 && q2 > v2) { v2 = q2; i2 = 2; }
    if (i1 != 3 && q3 > v2) { v2 = q3; i2 = 3; }
    float wsum = v1 + v2;
    float g1 = v1 / wsum, g2 = v2 / wsum;
    int lo = i1 < i2 ? i1 : i2, hi = i1 < i2 ? i2 : i1;
    float glo = i1 < i2 ? g1 : g2, ghi = i1 < i2 ? g2 : g1;
    int pidx = (lo == 0) ? (hi - 1) : ((lo == 1) ? (hi + 1) : 5);
    int combo = best * 6 + pidx;
    if (lane == 0) {
      int slot = atomicAdd(&cnt[combo], 1);
      list[(size_t)combo * T + slot] = t;
      gates[(size_t)t * 2] = glo;
      gates[(size_t)t * 2 + 1] = ghi;
    }
  }
}

struct MoeMap {
  int pre[25];
};
__device__ __forceinline__ void moe_find(const int* cnt, int tg, int& combo, int& mt, int& n, int& sbase) {
  int acc = 0;
  combo = 0;
  mt = 0;
  n = 0;
  sbase = 0;
  bool found = false;
  for (int c = 0; c < 24; ++c) {
    int cc = cnt[c];
    int nt = (cc + 127) >> 7;
    if (!found && tg < acc + nt) {
      combo = c;
      mt = tg - acc;
      n = cc;
      sbase = acc * 128;
      found = true;
    }
    acc += nt;
  }
}
__device__ __forceinline__ int moe_total_tiles(const int* cnt) {
  int acc = 0;
  for (int c = 0; c < 24; ++c) acc += (cnt[c] + 127) >> 7;
  return acc;
}
__device__ __forceinline__ void combo_experts(int combo, int& e1, int& e2) {
  int g = combo / 6, pi = combo % 6;
  int lo = pi < 3 ? 0 : (pi < 5 ? 1 : 2);
  int hi = pi < 3 ? pi + 1 : (pi < 5 ? pi - 1 : 3);
  e1 = g * 4 + lo;
  e2 = g * 4 + hi;
}

__device__ __forceinline__ void ph_moe_up(const P& p, int layer, int bid, int nb, char* smem) {
  const int* cnt = (const int*)(p.ws + OFF_CNT) + layer * 32;
  const int* list = (const int*)(p.ws + OFF_LIST);
  const float* gates = (const float*)(p.ws + OFF_GATES);
  const bf16_t* hbf = (const bf16_t*)(p.ws + OFF_S1);
  const bf16_t* W13 = (const bf16_t*)(p.ws + OFF_W13T);
  bf16_t* hid = (bf16_t*)(p.ws + OFF_HID);
  const int TT = moe_total_tiles(cnt);
  const int tid = threadIdx.x;
  for (int w = bid; w < TT * 16; w += nb) {
    int tg = w >> 4, nt = w & 15;
    int combo, mt, n, sbase;
    moe_find(cnt, tg, combo, mt, n, sbase);
    int e1, e2;
    combo_experts(combo, e1, e2);
    const int e = nt < 8 ? e1 : e2;
    const int* lst = list + (size_t)combo * T;
    const bf16_t* Bb = W13 + (size_t)e * 1048576 + (size_t)(nt & 7) * 128 * 1024;
    const bf16_t* arow[4];
#pragma unroll
    for (int i = 0; i < 4; ++i) {
      int slot = mt * 128 + (tid >> 3) + 32 * i;
      int tok = lst[slot < n ? slot : 0];
      arow[i] = hbf + (size_t)tok * 1024;
    }
    gemm_tile([&](int i, int r, int k) { return *(const bf16x8*)(arow[i] + k); },
              [&](int i, int r, int k) { return *(const bf16x8*)(Bb + (size_t)r * 1024 + k); }, 16,
              [&](f32x4(&acc)[4][4], int r0, int c0) {
                const int wc = c0 >> 6, fr = c0 & 15;
#pragma unroll
                for (int m = 0; m < 4; ++m)
#pragma unroll
                  for (int j = 0; j < 4; ++j) {
                    int row = r0 + m * 16 + j;
                    int slot = mt * 128 + row;
                    int tok = lst[slot < n ? slot : 0];
                    float gate = gates[(size_t)tok * 2 + (nt >> 3)];
#pragma unroll
                    for (int np = 0; np < 2; ++np) {
                      float a1 = acc[m][2 * np][j], a3 = acc[m][2 * np + 1][j];
                      int hc = (nt >> 3) * 512 + (nt & 7) * 64 + wc * 32 + np * 16 + fr;
                      hid[(size_t)(sbase + slot) * 1024 + hc] = f2bf(siluf_(a1) * a3 * gate);
                    }
                  }
              },
              smem);
  }
}

__device__ __forceinline__ void ph_moe_down(const P& p, int layer, int bid, int nb, char* smem) {
  const int* cnt = (const int*)(p.ws + OFF_CNT) + layer * 32;
  const int* list = (const int*)(p.ws + OFF_LIST);
  const float* mod = (const float*)(p.ws + OFF_MOD);
  const bf16_t* W2 = (const bf16_t*)(p.ws + OFF_W2T);
  const bf16_t* hid = (const bf16_t*)(p.ws + OFF_HID);
  const int TT = moe_total_tiles(cnt);
  for (int w = bid; w < TT * 8; w += nb) {
    int tg = w >> 3, nt = w & 7;
    int combo, mt, n, sbase;
    moe_find(cnt, tg, combo, mt, n, sbase);
    int e1, e2;
    combo_experts(combo, e1, e2);
    const int* lst = list + (size_t)combo * T;
    const bf16_t* Ab = hid + (size_t)(sbase + mt * 128) * 1024;
    const bf16_t* B1 = W2 + (size_t)e1 * 524288 + (size_t)nt * 128 * 512;
    const bf16_t* B2 = W2 + (size_t)e2 * 524288 + (size_t)nt * 128 * 512;
    gemm_tile([&](int i, int r, int k) { return *(const bf16x8*)(Ab + (size_t)r * 1024 + k); },
              [&](int i, int r, int k) {
                return k < 512 ? *(const bf16x8*)(B1 + (size_t)r * 512 + k)
                               : *(const bf16x8*)(B2 + (size_t)r * 512 + (k - 512));
              },
              16,
              [&](f32x4(&acc)[4][4], int r0, int c0) {
#pragma unroll
                for (int m = 0; m < 4; ++m)
#pragma unroll
                  for (int j = 0; j < 4; ++j) {
                    int slot = mt * 128 + r0 + m * 16 + j;
                    if (slot < n) {
                      int tok = lst[slot];
                      const float* gt = mod + (size_t)(layer * 4 + (tok >> 12)) * 6144 + 5120 + nt * 128;
                      float* orow = p.out + (size_t)tok * 1024 + nt * 128;
#pragma unroll
                      for (int nn = 0; nn < 4; ++nn) orow[c0 + nn * 16] += gt[c0 + nn * 16] * acc[m][nn][j];
                    }
                  }
              },
              smem);
  }
}

__device__ __forceinline__ void ph_norm1(const P& p, int bid, int nb) {
  const int lane = threadIdx.x & 63, wid = threadIdx.x >> 6;
  const float* mod = (const float*)(p.ws + OFF_MOD);
  bf16_t* hbf = (bf16_t*)(p.ws + OFF_S1);
  for (int t = bid * 4 + wid; t < T; t += nb * 4) {
    int b = t >> 12;
    const float* m0 = mod + (size_t)(1 * 4 + b) * 6144;
    float h[16];
    row_norm_mod(p.out + (size_t)t * 1024, p.norm_w + 2 * 1024, m0, m0 + 1024, lane, h);
    store_hbf(hbf + (size_t)t * 1024, lane, h);
  }
}

__device__ __forceinline__ void ph_gemm_rkv(const P& p, int bid, int nb, char* smem) {
  const bf16_t* hbf = (const bf16_t*)(p.ws + OFF_S1);
  const bf16_t* W = (const bf16_t*)(p.ws + OFF_WRKVT);
  const bf16_t* L1T = (const bf16_t*)(p.ws + OFF_LORA1T);
  bf16_t* lora1 = (bf16_t*)(p.ws + OFF_LORA1);
  for (int w = bid; w < 128 * 26; w += nb) {
    int mt = w % 128, nt = w / 128;
    const int m0 = mt * 128;
    if (nt < 24) {
      const int wi = nt >> 3, n0 = (nt & 7) * 128;
      const float* mu = p.mu + wi * 1024;
      const bf16_t* Bb = W + (size_t)wi * 1048576 + (size_t)n0 * 1024;
      bf16_t* C = (bf16_t*)(p.ws + OFF_R + (size_t)wi * 32 * MiB);
      gemm_tile(
          [&](int i, int r, int k) {
            int t = m0 + r;
            bf16x8 cur = *(const bf16x8*)(hbf + (size_t)t * 1024 + k);
            bf16x8 prv = (bf16x8){0, 0, 0, 0, 0, 0, 0, 0};
            if (t & (SEQ - 1)) prv = *(const bf16x8*)(hbf + (size_t)(t - 1) * 1024 + k);
            float4 m0v = *(const float4*)(mu + k), m1v = *(const float4*)(mu + k + 4);
            float mm[8] = {m0v.x, m0v.y, m0v.z, m0v.w, m1v.x, m1v.y, m1v.z, m1v.w};
            bf16x8 o;
#pragma unroll
            for (int j = 0; j < 8; ++j) {
              float c = bfs2f(cur[j]), pv = bfs2f(prv[j]);
              o[j] = (short)f2bf(c + (pv - c) * mm[j]);
            }
            return o;
          },
          [&](int i, int r, int k) { return *(const bf16x8*)(Bb + (size_t)r * 1024 + k); }, 16,
          [&](f32x4(&acc)[4][4], int r0, int c0) {
#pragma unroll
            for (int m = 0; m < 4; ++m)
#pragma unroll
              for (int n = 0; n < 4; ++n)
#pragma unroll
                for (int j = 0; j < 4; ++j)
                  C[(size_t)(m0 + r0 + m * 16 + j) * 1024 + n0 + c0 + n * 16] = f2bf(acc[m][n][j]);
          },
          smem);
    } else {
      const int n0 = (nt - 24) * 128;
      const bf16_t* Bb = L1T + (size_t)n0 * 2048;
      gemm_tile(
          [&](int i, int r, int k) {
            int t = m0 + r;
            if (k < 1024) return *(const bf16x8*)(hbf + (size_t)t * 1024 + k);
            int kk = k - 1024;
            bf16x8 cur = *(const bf16x8*)(hbf + (size_t)t * 1024 + kk);
            bf16x8 prv = (bf16x8){0, 0, 0, 0, 0, 0, 0, 0};
            if (t & (SEQ - 1)) prv = *(const bf16x8*)(hbf + (size_t)(t - 1) * 1024 + kk);
            bf16x8 o;
#pragma unroll
            for (int j = 0; j < 8; ++j) o[j] = (short)f2bf(bfs2f(prv[j]) - bfs2f(cur[j]));
            return o;
          },
          [&](int i, int r, int k) { return *(const bf16x8*)(Bb + (size_t)r * 2048 + k); }, 32,
          [&](f32x4(&acc)[4][4], int r0, int c0) {
#pragma unroll
            for (int m = 0; m < 4; ++m)
#pragma unroll
              for (int n = 0; n < 4; ++n)
#pragma unroll
                for (int j = 0; j < 4; ++j) {
                  int col = n0 + c0 + n * 16;
                  float v = acc[m][n][j];
                  float r = col < 64 ? tanhf(v) : (col < 128 ? v : sigmoidf_(v));
                  lora1[(size_t)(m0 + r0 + m * 16 + j) * 256 + col] = f2bf(r);
                }
          },
          smem);
    }
  }
}

__device__ __forceinline__ void ph_gemm_lora2(const P& p, int bid, int nb, char* smem) {
  const bf16_t* lora1 = (const bf16_t*)(p.ws + OFF_LORA1);
  float* wdec = (float*)(p.ws + OFF_S2);
  bf16_t* aa = (bf16_t*)(p.ws + OFF_AA);
  bf16_t* gg = (bf16_t*)(p.ws + OFF_G);
  for (int w = bid; w < 128 * 24; w += nb) {
    int mt = w % 128, rest = w / 128, which = rest >> 3, nt = rest & 7;
    const int m0 = mt * 128, n0 = nt * 128;
    const int K = which == 2 ? 128 : 64;
    const int aoff = which == 0 ? 0 : (which == 1 ? 64 : 128);
    const bf16_t* Bt = (const bf16_t*)(p.ws + (which == 0 ? OFF_DEC2T : (which == 1 ? OFF_A2T : OFF_G2T)));
    const bf16_t* Ab = lora1 + (size_t)m0 * 256 + aoff;
    const bf16_t* Bb = Bt + (size_t)n0 * K;
    gemm_tile([&](int i, int r, int k) { return *(const bf16x8*)(Ab + (size_t)r * 256 + k); },
              [&](int i, int r, int k) { return *(const bf16x8*)(Bb + (size_t)r * K + k); }, K / 64,
              [&](f32x4(&acc)[4][4], int r0, int c0) {
#pragma unroll
                for (int m = 0; m < 4; ++m)
#pragma unroll
                  for (int n = 0; n < 4; ++n)
#pragma unroll
                    for (int j = 0; j < 4; ++j) {
                      int col = n0 + c0 + n * 16;
                      size_t idx = (size_t)(m0 + r0 + m * 16 + j) * 1024 + col;
                      float v = acc[m][n][j];
                      if (which == 0) {
                        float wl = -softplusf_(-(p.dec0[col] + v)) - 0.5f;
                        wdec[idx] = __expf(-__expf(wl));
                      } else if (which == 1) {
                        aa[idx] = f2bf(sigmoidf_(p.a0[col] + v));
                      } else {
                        gg[idx] = f2bf(v);
                      }
                    }
              },
              smem);
  }
}

__device__ __forceinline__ void ph_prep1(const P& p, int bid, int nb) {
  const int lane = threadIdx.x & 63, wid = threadIdx.x >> 6;
  const bf16_t* R = (const bf16_t*)(p.ws + OFF_R);
  bf16_t* Kb = (bf16_t*)(p.ws + OFF_K);
  bf16_t* KK = (bf16_t*)(p.ws + OFF_KK);
  const bf16_t* AA = (const bf16_t*)(p.ws + OFF_AA);
  float* bonus = (float*)(p.ws + OFF_BONUS);
  const int c0 = lane * 16;
  for (int t = bid * 4 + wid; t < T; t += nb * 4) {
    size_t base = (size_t)t * 1024 + c0;
    float kv[16], av[16], rv[16];
#pragma unroll
    for (int i = 0; i < 2; ++i) {
      bf16x8 k8 = *(const bf16x8*)(Kb + base + i * 8), a8 = *(const bf16x8*)(AA + base + i * 8),
             r8 = *(const bf16x8*)(R + base + i * 8);
#pragma unroll
      for (int j = 0; j < 8; ++j) {
        kv[i * 8 + j] = bfs2f(k8[j]);
        av[i * 8 + j] = bfs2f(a8[j]);
        rv[i * 8 + j] = bfs2f(r8[j]);
      }
    }
    float kkv[16], kh[16];
    float ss = 0.f, bon = 0.f;
#pragma unroll
    for (int j = 0; j < 16; ++j) {
      kkv[j] = kv[j] * p.k_k[c0 + j];
      ss += kkv[j] * kkv[j];
      kh[j] = kv[j] * (1.f + (av[j] - 1.f) * p.k_a[c0 + j]);
      bon += rv[j] * kh[j] * p.r_k[c0 + j];
    }
    ss += __shfl_xor(ss, 1, 64);
    ss += __shfl_xor(ss, 2, 64);
    bon += __shfl_xor(bon, 1, 64);
    bon += __shfl_xor(bon, 2, 64);
    float inv = 1.f / fmaxf(sqrtf(ss), 1e-12f);
#pragma unroll
    for (int i = 0; i < 2; ++i) {
      bf16x8 o1, o2;
#pragma unroll
      for (int j = 0; j < 8; ++j) {
        o1[j] = (short)f2bf(kkv[i * 8 + j] * inv);
        o2[j] = (short)f2bf(kh[i * 8 + j]);
      }
      *(bf16x8*)(KK + base + i * 8) = o1;
      *(bf16x8*)(Kb + base + i * 8) = o2;
    }
    if ((lane & 3) == 0) bonus[(size_t)t * 16 + (lane >> 2)] = bon;
  }
}

__device__ __forceinline__ void ph_scan1(const P& p, int bid, int nb, char* smem) {
  bf16_t* R = (bf16_t*)(p.ws + OFF_R);
  const bf16_t* Kb = (const bf16_t*)(p.ws + OFF_K);
  const bf16_t* V = (const bf16_t*)(p.ws + OFF_V);
  const bf16_t* KK = (const bf16_t*)(p.ws + OFF_KK);
  const bf16_t* AA = (const bf16_t*)(p.ws + OFF_AA);
  const float* W = (const float*)(p.ws + OFF_S2);
  const int tid = threadIdx.x;
  float* rs = (float*)smem;
  float* ws_ = rs + 1024;
  float* ks = ws_ + 1024;
  float* ns = ks + 1024;
  float* bs = ns + 1024;
  float* vs = bs + 1024;
  for (int u = bid; u < 64; u += nb) {
    const int b = u >> 4, hd = u & 15;
    const int vr = tid >> 2, qd = tid & 3;
    float S[16];
#pragma unroll
    for (int k = 0; k < 16; ++k) S[k] = 0.f;
    const int st_l = tid >> 4, k0_l = (tid & 15) * 4;
    for (int t0 = 0; t0 < SEQ; t0 += 16) {
      __syncthreads();
      {
        size_t base = (size_t)(b * SEQ + t0 + st_l) * 1024 + hd * 64 + k0_l;
        bf16x4 r4 = *(const bf16x4*)(R + base), k4 = *(const bf16x4*)(Kb + base), v4 = *(const bf16x4*)(V + base),
               kk4 = *(const bf16x4*)(KK + base), a4 = *(const bf16x4*)(AA + base);
        float4 w4 = *(const float4*)(W + base);
        float ww[4] = {w4.x, w4.y, w4.z, w4.w};
#pragma unroll
        for (int j = 0; j < 4; ++j) {
          int li = st_l * 64 + k0_l + j;
          float kkf = bfs2f(kk4[j]);
          rs[li] = bfs2f(r4[j]);
          ws_[li] = ww[j];
          ks[li] = bfs2f(k4[j]);
          ns[li] = -kkf;
          bs[li] = kkf * bfs2f(a4[j]);
          vs[li] = bfs2f(v4[j]);
        }
      }
      __syncthreads();
      for (int st = 0; st < 16; ++st) {
        const int o = st * 64 + qd * 16;
        float vv = vs[st * 64 + vr];
        float sa = 0.f;
#pragma unroll
        for (int k = 0; k < 16; ++k) sa += S[k] * ns[o + k];
        sa += __shfl_xor(sa, 1, 64);
        sa += __shfl_xor(sa, 2, 64);
        float y = 0.f;
#pragma unroll
        for (int k = 0; k < 16; ++k) {
          S[k] = S[k] * ws_[o + k] + sa * bs[o + k] + vv * ks[o + k];
          y += S[k] * rs[o + k];
        }
        y += __shfl_xor(y, 1, 64);
        y += __shfl_xor(y, 2, 64);
        if (qd == 0) R[(size_t)(b * SEQ + t0 + st) * 1024 + hd * 64 + vr] = f2bf(y);
      }
    }
  }
}

__device__ __forceinline__ void ph_post1(const P& p, int bid, int nb) {
  const int lane = threadIdx.x & 63, wid = threadIdx.x >> 6;
  const bf16_t* Y = (const bf16_t*)(p.ws + OFF_R);
  const bf16_t* V = (const bf16_t*)(p.ws + OFF_V);
  const bf16_t* G = (const bf16_t*)(p.ws + OFF_G);
  const float* bonus = (const float*)(p.ws + OFF_BONUS);
  bf16_t* o = (bf16_t*)(p.ws + OFF_S1);
  const int c0 = lane * 16;
  for (int t = bid * 4 + wid; t < T; t += nb * 4) {
    size_t base = (size_t)t * 1024 + c0;
    float yv[16], vv[16], gv[16];
    float s = 0.f;
#pragma unroll
    for (int i = 0; i < 2; ++i) {
      bf16x8 y8 = *(const bf16x8*)(Y + base + i * 8), v8 = *(const bf16x8*)(V + base + i * 8),
             g8 = *(const bf16x8*)(G + base + i * 8);
#pragma unroll
      for (int j = 0; j < 8; ++j) {
        yv[i * 8 + j] = bfs2f(y8[j]);
        vv[i * 8 + j] = bfs2f(v8[j]);
        gv[i * 8 + j] = bfs2f(g8[j]);
        s += yv[i * 8 + j];
      }
    }
    s += __shfl_xor(s, 1, 64);
    s += __shfl_xor(s, 2, 64);
    float mean = s * (1.f / 64.f);
    float var = 0.f;
#pragma unroll
    for (int j = 0; j < 16; ++j) var += (yv[j] - mean) * (yv[j] - mean);
    var += __shfl_xor(var, 1, 64);
    var += __shfl_xor(var, 2, 64);
    float rstd = rsqrtf(var * (1.f / 64.f) + 64e-5f);
    float bon = bonus[(size_t)t * 16 + (lane >> 2)];
#pragma unroll
    for (int i = 0; i < 2; ++i) {
      bf16x8 o8;
#pragma unroll
      for (int j = 0; j < 8; ++j) {
        int c = c0 + i * 8 + j;
        float val = (yv[i * 8 + j] - mean) * rstd * p.ln_w[c] + p.ln_b[c] + bon * vv[i * 8 + j];
        o8[j] = (short)f2bf(val * gv[i * 8 + j]);
      }
      *(bf16x8*)(o + base + i * 8) = o8;
    }
  }
}

__device__ __forceinline__ void ph_final(const P& p, int bid, int nb) {
  const int lane = threadIdx.x & 63, wid = threadIdx.x >> 6;
  for (int t = bid * 4 + wid; t < T; t += nb * 4) {
    float4* xr = (float4*)(p.out + (size_t)t * 1024);
    float4 v[4];
    float ss = 0;
#pragma unroll
    for (int i = 0; i < 4; ++i) {
      v[i] = xr[lane + 64 * i];
      ss += v[i].x * v[i].x + v[i].y * v[i].y + v[i].z * v[i].z + v[i].w * v[i].w;
    }
    ss = wave_sum(ss);
    float rstd = rsqrtf(ss * (1.f / 1024.f) + 1e-6f);
#pragma unroll
    for (int i = 0; i < 4; ++i) {
      float4 w4 = *(const float4*)(p.final_w + (lane + 64 * i) * 4);
      float4 o;
      o.x = v[i].x * rstd * w4.x;
      o.y = v[i].y * rstd * w4.y;
      o.z = v[i].z * rstd * w4.z;
      o.w = v[i].w * rstd * w4.w;
      xr[lane + 64 * i] = o;
    }
  }
}

constexpr int NPHASE = 25;
template <int PH>
__device__ __forceinline__ void run_phase(const P& p, int bid, int nb, char* smem) {
  const float* mod = (const float*)(p.ws + OFF_MOD);
  if (PH == 0) { ph_prep(p, bid, nb, smem); ph_conv_w0(p, bid, nb, smem); }
  else if (PH == 1) ph_norm0(p, bid, nb);
  else if (PH == 2) ph_gemm_inproj(p, bid, nb, smem);
  else if (PH == 3) ph_conv(p, bid, nb);
  else if (PH == 4) ph_scan0(p, bid, nb, smem);
  else if (PH == 5) ph_norms0(p, bid, nb);
  else if (PH == 6) ph_gemm_resid<true>(p, (const bf16_t*)(p.ws + OFF_S2), 2048, (const bf16_t*)(p.ws + OFF_WOUTT), 2048, mod + 2048, bid, nb, smem);
  else if (PH == 7) { ph_route(p, 0, bid, nb); ph_conv_moe(p, 0, bid, nb, smem); ph_conv_w1(p, bid, nb, smem); }
  else if (PH == 8) ph_moe_up(p, 0, bid, nb, smem);
  else if (PH == 9) ph_moe_down(p, 0, bid, nb, smem);
  else if (PH == 10) ph_norm1(p, bid, nb);
  else if (PH == 11) ph_gemm_rkv(p, bid, nb, smem);
  else if (PH == 12) ph_gemm_lora2(p, bid, nb, smem);
  else if (PH == 13) ph_prep1(p, bid, nb);
  else if (PH == 14) ph_scan1(p, bid, nb, smem);
  else if (PH == 15) ph_post1(p, bid, nb);
  else if (PH == 16) ph_gemm_resid<false>(p, (const bf16_t*)(p.ws + OFF_S1), 1024, (const bf16_t*)(p.ws + OFF_WOT), 1024, mod + 4 * 6144 + 2048, bid, nb, smem);
  else if (PH == 17) { ph_route(p, 1, bid, nb); ph_conv_moe(p, 1, bid, nb, smem); }
  else if (PH == 18) ph_moe_up(p, 1, bid, nb, smem);
  else if (PH == 19) ph_moe_down(p, 1, bid, nb, smem);
  else if (PH == 20) ph_final(p, bid, nb);
}

template <int PH>
__global__ void __launch_bounds__(256) k_phase(P p) {
  __shared__ __attribute__((aligned(16))) char smem[SMEM_BYTES];
  run_phase<PH>(p, blockIdx.x, gridDim.x, smem);
}

template <int PH>
static void launch_phases(const P& p, hipStream_t stream) {
  if constexpr (PH < 21) {
    hipLaunchKernelGGL(k_phase<PH>, dim3(1024), dim3(256), 0, stream, p);
    launch_phases<PH + 1>(p, stream);
  }
}

extern "C" void kernel_launch(void* const* d_in, const int* in_sizes, int n_in, void* d_out, int out_size, void* d_ws,
                              size_t ws_size, hipStream_t stream) {
  P p{};
  const float** pp = (const float**)&p;
  for (int i = 0; i < 37; ++i) pp[i] = (const float*)d_in[i];
  p.out = (float*)d_out;
  p.ws = (char*)d_ws;
  if (ws_size < WS_NEED) fprintf(stderr, "workspace too small: %zu < %zu\n", ws_size, (size_t)WS_NEED);
  launch_phases<0>(p, stream);
}
```

```cpp
#include <hip/hip_runtime.h>
#include <hip/hip_cooperative_groups.h>
#include <stdint.h>
#include <stdio.h>

typedef unsigned short bf16_t;
typedef __attribute__((ext_vector_type(8))) short bf16x8;
typedef __attribute__((ext_vector_type(4))) short bf16x4;
typedef __attribute__((ext_vector_type(4))) float f32x4;

constexpr int T = 16384;
constexpr int SEQ = 4096;
constexpr int NPROJ = 6656;

constexpr size_t MiB = 1048576;
constexpr size_t OFF_MOD = 0;
constexpr size_t OFF_LB = 196608;
constexpr size_t OFF_CNT = 200704;
constexpr size_t OFF_DT = 200960;
constexpr size_t OFF_GATES = OFF_DT + (size_t)T * 16 * 4;
constexpr size_t OFF_BONUS = OFF_GATES + (size_t)T * 2 * 4;
constexpr size_t OFF_LIST = OFF_BONUS + (size_t)T * 16 * 4;
constexpr size_t OFF_WA = 8 * MiB;
constexpr size_t OFF_S1 = 28 * MiB;
constexpr size_t OFF_S2 = 60 * MiB;
constexpr size_t OFF_BIG = 124 * MiB;
constexpr size_t WS_NEED = 340 * MiB;
constexpr size_t OFF_WINT = OFF_WA;
constexpr size_t OFF_WOUTT = OFF_WA + 13 * MiB;
constexpr size_t OFF_WRKVT = OFF_WA;
constexpr size_t OFF_WOT = OFF_WA + 6 * MiB;
constexpr size_t OFF_LORA1T = OFF_WA + 8 * MiB;
constexpr size_t OFF_DEC2T = OFF_WA + 9 * MiB;
constexpr size_t OFF_A2T = OFF_DEC2T + 131072;
constexpr size_t OFF_G2T = OFF_A2T + 131072;
constexpr size_t OFF_PROJ = OFF_BIG;
constexpr size_t OFF_W13T = OFF_BIG;
constexpr size_t OFF_W2T = OFF_BIG + 32 * MiB;
constexpr size_t OFF_HID = OFF_BIG + 48 * MiB;
constexpr size_t OFF_R = OFF_BIG;
constexpr size_t OFF_K = OFF_BIG + 32 * MiB;
constexpr size_t OFF_V = OFF_BIG + 64 * MiB;
constexpr size_t OFF_KK = OFF_BIG + 96 * MiB;
constexpr size_t OFF_AA = OFF_BIG + 128 * MiB;
constexpr size_t OFF_G = OFF_BIG + 160 * MiB;
constexpr size_t OFF_LORA1 = OFF_BIG + 192 * MiB;

struct P {
  const float *x, *c, *mod_w, *mod_b, *norm_w, *lb_logits, *w_in, *hg_norm, *conv_w, *conv_b, *dt_bias, *a_log,
      *d_skip, *ssm_norm, *w_out, *mu, *w_rkv, *dec0, *dec1, *dec2, *a0, *a1, *a2, *g1, *g2, *k_k, *k_a, *r_k,
      *ln_w, *ln_b, *w_o, *router_w, *router_b, *moe_w1, *moe_w3, *moe_w2, *final_w;
  float* out;
  char* ws;
};

__device__ __forceinline__ float bf2f(bf16_t h) { return __uint_as_float(((uint32_t)h) << 16); }
__device__ __forceinline__ float bfs2f(short h) { return __uint_as_float(((uint32_t)(unsigned short)h) << 16); }
__device__ __forceinline__ bf16_t f2bf(float f) {
  uint32_t u = __float_as_uint(f);
  u += 0x7fffu + ((u >> 16) & 1u);
  return (bf16_t)(u >> 16);
}
__device__ __forceinline__ float sigmoidf_(float x) { return 1.f / (1.f + __expf(-x)); }
__device__ __forceinline__ float siluf_(float x) { return x / (1.f + __expf(-x)); }
__device__ __forceinline__ float softplusf_(float x) { return x > 20.f ? x : log1pf(__expf(x)); }
__device__ __forceinline__ float wave_sum(float v) {
#pragma unroll
  for (int m = 32; m >= 1; m >>= 1) v += __shfl_xor(v, m, 64);
  return v;
}
__device__ __forceinline__ uint2 pack4(float a, float b, float c, float d) {
  uint2 r;
  r.x = (uint32_t)f2bf(a) | ((uint32_t)f2bf(b) << 16);
  r.y = (uint32_t)f2bf(c) | ((uint32_t)f2bf(d) << 16);
  return r;
}

__device__ __forceinline__ void store16(bf16_t* dst, const f32x4 (&a)[4]) {
  bf16x8 o0, o1;
#pragma unroll
  for (int j = 0; j < 4; ++j) {
    o0[j] = (short)f2bf(a[0][j]);
    o0[4 + j] = (short)f2bf(a[1][j]);
    o1[j] = (short)f2bf(a[2][j]);
    o1[4 + j] = (short)f2bf(a[3][j]);
  }
  *(bf16x8*)dst = o0;
  *(bf16x8*)(dst + 8) = o1;
}

constexpr int LSTR = 144;
constexpr int SMEM_BYTES = 2 * 128 * LSTR;

template <class AF, class BF, class EF>
__device__ __forceinline__ void gemm_tile(AF af, BF bf, int nk, EF ef, char* smem) {
  const int tid = threadIdx.x, lane = tid & 63, wid = tid >> 6, wr = wid >> 1, wc = wid & 1, fr = lane & 15,
            fq = lane >> 4;
  char* sA = smem;
  char* sB = smem + 128 * LSTR;
  const int lrow = tid >> 3, lkc = tid & 7;
  bf16x8 ra[4], rb[4];
  f32x4 acc[4][4];
#pragma unroll
  for (int m = 0; m < 4; ++m)
#pragma unroll
    for (int n = 0; n < 4; ++n) acc[m][n] = (f32x4){0.f, 0.f, 0.f, 0.f};
#pragma unroll
  for (int i = 0; i < 4; ++i) {
    ra[i] = af(i, lrow + 32 * i, lkc * 8);
    rb[i] = bf(i, lrow + 32 * i, lkc * 8);
  }
  for (int kt = 0; kt < nk; ++kt) {
    __syncthreads();
#pragma unroll
    for (int i = 0; i < 4; ++i) {
      *(bf16x8*)(sA + (lrow + 32 * i) * LSTR + lkc * 16) = ra[i];
      *(bf16x8*)(sB + (lrow + 32 * i) * LSTR + lkc * 16) = rb[i];
    }
    __syncthreads();
    if (kt + 1 < nk) {
#pragma unroll
      for (int i = 0; i < 4; ++i) {
        ra[i] = af(i, lrow + 32 * i, (kt + 1) * 64 + lkc * 8);
        rb[i] = bf(i, lrow + 32 * i, (kt + 1) * 64 + lkc * 8);
      }
    }
#pragma unroll
    for (int s = 0; s < 2; ++s) {
      bf16x8 a[4], b[4];
#pragma unroll
      for (int m = 0; m < 4; ++m) a[m] = *(const bf16x8*)(sA + (wr * 64 + m * 16 + fr) * LSTR + s * 64 + fq * 16);
#pragma unroll
      for (int n = 0; n < 4; ++n) b[n] = *(const bf16x8*)(sB + (wc * 64 + n * 16 + fr) * LSTR + s * 64 + fq * 16);
#pragma unroll
      for (int m = 0; m < 4; ++m)
#pragma unroll
        for (int n = 0; n < 4; ++n) acc[m][n] = __builtin_amdgcn_mfma_f32_16x16x32_bf16(b[n], a[m], acc[m][n], 0, 0, 0);
    }
  }
  ef(acc, wr * 64 + fr, wc * 64 + fq * 16);
}

__device__ __forceinline__ void ph_prep(const P& p, int bid, int nb, char* smem) {
  float* sc = (float*)smem;
  float* red = sc + 4096;
  const int tid = threadIdx.x;
  float* mod = (float*)(p.ws + OFF_MOD);
  for (int i = tid; i < 4096; i += 256) sc[i] = siluf_(p.c[i]);
  __syncthreads();
  for (int u = bid; u < 192; u += nb) {
    int l = u / 96, e0 = (u % 96) * 64;
    int kq = tid >> 6, col = tid & 63;
    const float* w = p.mod_w + ((size_t)l * 1024 + kq * 256) * 6144 + e0 + col;
    float a0 = 0, a1 = 0, a2 = 0, a3 = 0;
    for (int d = 0; d < 256; ++d) {
      float wv = w[(size_t)d * 6144];
      int dd = kq * 256 + d;
      a0 += sc[dd] * wv;
      a1 += sc[1024 + dd] * wv;
      a2 += sc[2048 + dd] * wv;
      a3 += sc[3072 + dd] * wv;
    }
    red[(kq * 64 + col) * 4 + 0] = a0;
    red[(kq * 64 + col) * 4 + 1] = a1;
    red[(kq * 64 + col) * 4 + 2] = a2;
    red[(kq * 64 + col) * 4 + 3] = a3;
    __syncthreads();
    {
      int b = tid >> 6, c2 = tid & 63;
      float s = 0;
      for (int q = 0; q < 4; ++q) s += red[(q * 64 + c2) * 4 + b];
      mod[(l * 4 + b) * 6144 + e0 + c2] = s + p.mod_b[l * 6144 + e0 + c2];
    }
    __syncthreads();
  }
  if (bid == 0) {
    float* lb = (float*)(p.ws + OFF_LB);
    for (int ch = tid; ch < 1024; ch += 256) {
      float l0 = p.lb_logits[ch], l1 = p.lb_logits[1024 + ch], l2 = p.lb_logits[2048 + ch];
      float m = fmaxf(l0, fmaxf(l1, l2));
      float e0 = __expf(l0 - m), e1 = __expf(l1 - m), e2 = __expf(l2 - m);
      lb[ch] = e1 / (e0 + e1 + e2);
    }
    int* cnt = (int*)(p.ws + OFF_CNT);
    if (tid < 64) cnt[tid] = 0;
  }
}

template <int MODE>
__device__ __forceinline__ int rowmap(int n) {
  if (MODE == 0) return (n & ~63) + ((n >> 2) & 3) * 16 + ((n >> 4) & 3) * 4 + (n & 3);
  int nt8 = n >> 6, wc = (n >> 5) & 1, fq = (n >> 3) & 3, np = (n >> 2) & 1, j = n & 3;
  return nt8 * 128 + wc * 64 + (2 * np + (MODE - 1)) * 16 + fq * 4 + j;
}
template <int MODE>
__device__ __forceinline__ void conv_mat(const float* src, int lds_, int K, int N, bf16_t* dst, int ldd, int dk0, const float* scale,
                         int bid, int nb, char* smem, int smode = 1) {
  float* tile = (float*)smem;
  const int tid = threadIdx.x;
  const int tn = N >> 6, ntile = (K >> 6) * tn;
  for (int t = bid; t < ntile; t += nb) {
    int k0 = (t / tn) * 64, n0 = (t % tn) * 64;
    __syncthreads();
#pragma unroll
    for (int i = 0; i < 16; ++i) {
      int idx = tid + i * 256, r = idx >> 6, cc = idx & 63;
      float v = src[(size_t)(k0 + r) * lds_ + n0 + cc];
      if (scale) v *= (smode == 1 ? scale[k0 + r] : 1.f - scale[k0 + r]);
      tile[r * 65 + cc] = v;
    }
    __syncthreads();
#pragma unroll
    for (int i = 0; i < 2; ++i) {
      int idx = tid + i * 256, n = idx >> 3, kc = idx & 7;
      bf16x8 o;
#pragma unroll
      for (int j = 0; j < 8; ++j) o[j] = (short)f2bf(tile[(kc * 8 + j) * 65 + n]);
      *(bf16x8*)(dst + (size_t)rowmap<MODE>(n0 + n) * ldd + dk0 + k0 + kc * 8) = o;
    }
  }
  __syncthreads();
}
__device__ __forceinline__ void ph_conv_w0(const P& p, int bid, int nb, char* smem) {
  conv_mat<0>(p.w_in, 6672, 1024, NPROJ, (bf16_t*)(p.ws + OFF_WINT), 1024, 0, nullptr, bid, nb, smem);
  conv_mat<0>(p.w_out, 1024, 2048, 1024, (bf16_t*)(p.ws + OFF_WOUTT), 2048, 0, nullptr, bid, nb, smem);
}
__device__ __forceinline__ void ph_conv_w1(const P& p, int bid, int nb, char* smem) {
  for (int i = 0; i < 3; ++i)
    conv_mat<0>(p.w_rkv + (size_t)i * 1048576, 1024, 1024, 1024, (bf16_t*)(p.ws + OFF_WRKVT) + (size_t)i * 1048576,
                1024, 0, nullptr, bid, nb, smem);
  conv_mat<0>(p.w_o, 1024, 1024, 1024, (bf16_t*)(p.ws + OFF_WOT), 1024, 0, nullptr, bid, nb, smem);
  bf16_t* l1 = (bf16_t*)(p.ws + OFF_LORA1T);
  conv_mat<0>(p.dec1, 64, 1024, 64, l1, 2048, 0, p.mu + 3 * 1024, bid, nb, smem, 2);
  conv_mat<0>(p.dec1, 64, 1024, 64, l1, 2048, 1024, p.mu + 3 * 1024, bid, nb, smem);
  conv_mat<0>(p.a1, 64, 1024, 64, l1 + 64 * 2048, 2048, 0, p.mu + 4 * 1024, bid, nb, smem, 2);
  conv_mat<0>(p.a1, 64, 1024, 64, l1 + 64 * 2048, 2048, 1024, p.mu + 4 * 1024, bid, nb, smem);
  conv_mat<0>(p.g1, 128, 1024, 128, l1 + 128 * 2048, 2048, 0, p.mu + 5 * 1024, bid, nb, smem, 2);
  conv_mat<0>(p.g1, 128, 1024, 128, l1 + 128 * 2048, 2048, 1024, p.mu + 5 * 1024, bid, nb, smem);
  conv_mat<0>(p.dec2, 1024, 64, 1024, (bf16_t*)(p.ws + OFF_DEC2T), 64, 0, nullptr, bid, nb, smem);
  conv_mat<0>(p.a2, 1024, 64, 1024, (bf16_t*)(p.ws + OFF_A2T), 64, 0, nullptr, bid, nb, smem);
  conv_mat<0>(p.g2, 1024, 128, 1024, (bf16_t*)(p.ws + OFF_G2T), 128, 0, nullptr, bid, nb, smem);
}
__device__ __forceinline__ void ph_conv_moe(const P& p, int layer, int bid, int nb, char* smem) {
  for (int e = 0; e < 16; ++e) {
    size_t so = ((size_t)layer * 16 + e) * 524288;
    bf16_t* d13 = (bf16_t*)(p.ws + OFF_W13T) + (size_t)e * 1048576;
    conv_mat<1>(p.moe_w1 + so, 512, 1024, 512, d13, 1024, 0, nullptr, bid, nb, smem);
    conv_mat<2>(p.moe_w3 + so, 512, 1024, 512, d13, 1024, 0, nullptr, bid, nb, smem);
    conv_mat<0>(p.moe_w2 + so, 1024, 512, 1024, (bf16_t*)(p.ws + OFF_W2T) + (size_t)e * 524288, 512, 0, nullptr, bid,
                nb, smem);
  }
}

__device__ __forceinline__ void row_norm_mod(const float* xrow, const float* nw, const float* sh, const float* sc,
                                             int lane, float (&h)[16]) {
  const float4* xr = (const float4*)xrow;
  float4 v[4];
  float ss = 0;
#pragma unroll
  for (int i = 0; i < 4; ++i) {
    v[i] = xr[lane + 64 * i];
    ss += v[i].x * v[i].x + v[i].y * v[i].y + v[i].z * v[i].z + v[i].w * v[i].w;
  }
  ss = wave_sum(ss);
  float rstd = rsqrtf(ss * (1.f / 1024.f) + 1e-6f);
#pragma unroll
  for (int i = 0; i < 4; ++i) {
    int d0 = (lane + 64 * i) * 4;
    float4 w4 = *(const float4*)(nw + d0), s4 = *(const float4*)(sh + d0), c4 = *(const float4*)(sc + d0);
    h[i * 4 + 0] = v[i].x * rstd * w4.x * (1.f + c4.x) + s4.x;
    h[i * 4 + 1] = v[i].y * rstd * w4.y * (1.f + c4.y) + s4.y;
    h[i * 4 + 2] = v[i].z * rstd * w4.z * (1.f + c4.z) + s4.z;
    h[i * 4 + 3] = v[i].w * rstd * w4.w * (1.f + c4.w) + s4.w;
  }
}
__device__ __forceinline__ void store_hbf(bf16_t* hrow, int lane, const float (&h)[16]) {
#pragma unroll
  for (int i = 0; i < 4; ++i) {
    int d0 = (lane + 64 * i) * 4;
    *(uint2*)(hrow + d0) = pack4(h[i * 4], h[i * 4 + 1], h[i * 4 + 2], h[i * 4 + 3]);
  }
}

__device__ __forceinline__ void ph_norm0(const P& p, int bid, int nb) {
  const int lane = threadIdx.x & 63, wid = threadIdx.x >> 6;
  const float* mod = (const float*)(p.ws + OFF_MOD);
  bf16_t* hbf = (bf16_t*)(p.ws + OFF_S1);
  float* dt = (float*)(p.ws + OFF_DT);
  for (int t = bid * 4 + wid; t < T; t += nb * 4) {
    int b = t >> 12;
    const float* m0 = mod + (size_t)(0 * 4 + b) * 6144;
    float h[16];
    row_norm_mod(p.x + (size_t)t * 1024, p.norm_w + 0, m0, m0 + 1024, lane, h);
    store_hbf(hbf + (size_t)t * 1024, lane, h);
    float da[16];
#pragma unroll
    for (int j = 0; j < 16; ++j) da[j] = 0.f;
#pragma unroll
    for (int i = 0; i < 4; ++i) {
#pragma unroll
      for (int j = 0; j < 4; ++j) {
        int d = (lane + 64 * i) * 4 + j;
        const float4* wd = (const float4*)(p.w_in + (size_t)d * 6672 + NPROJ);
        float hv = h[i * 4 + j];
#pragma unroll
        for (int q = 0; q < 4; ++q) {
          float4 w4 = wd[q];
          da[q * 4 + 0] += hv * w4.x;
          da[q * 4 + 1] += hv * w4.y;
          da[q * 4 + 2] += hv * w4.z;
          da[q * 4 + 3] += hv * w4.w;
        }
      }
    }
    float val = 0.f;
#pragma unroll
    for (int j = 0; j < 16; ++j) {
      float s = wave_sum(da[j]);
      if (lane == j) val = s;
    }
    if (lane < 16) dt[(size_t)t * 16 + lane] = softplusf_(val + p.dt_bias[lane]);
  }
}

__device__ __forceinline__ void ph_gemm_inproj(const P& p, int bid, int nb, char* smem) {
  const bf16_t* A = (const bf16_t*)(p.ws + OFF_S1);
  const bf16_t* B = (const bf16_t*)(p.ws + OFF_WINT);
  bf16_t* C = (bf16_t*)(p.ws + OFF_PROJ);
  const int MT = 128, NT = 52;
  for (int w = bid; w < MT * NT; w += nb) {
    int mt = w % MT, nt = w / MT;
    const bf16_t* Ab = A + (size_t)mt * 128 * 1024;
    const bf16_t* Bb = B + (size_t)nt * 128 * 1024;
    bf16_t* Cb = C + (size_t)mt * 128 * NPROJ + nt * 128;
    gemm_tile([&](int i, int r, int k) { return *(const bf16x8*)(Ab + (size_t)r * 1024 + k); },
              [&](int i, int r, int k) { return *(const bf16x8*)(Bb + (size_t)r * 1024 + k); }, 16,
              [&](f32x4(&acc)[4][4], int r0, int c0) {
#pragma unroll
                for (int m = 0; m < 4; ++m) store16(Cb + (size_t)(r0 + m * 16) * NPROJ + c0, acc[m]);
              },
              smem);
  }
}

template <bool FIRST>
__device__ __forceinline__ void ph_gemm_resid(const P& p, const bf16_t* A, int lda, const bf16_t* B, int K, const float* gate,
                              int bid, int nb, char* smem) {
  for (int w = bid; w < 128 * 8; w += nb) {
    int mt = w % 128, nt = w / 128;
    const bf16_t* Ab = A + (size_t)mt * 128 * lda;
    const bf16_t* Bb = B + (size_t)nt * 128 * K;
    const float* gt = gate + (size_t)(mt >> 5) * 6144 + nt * 128;
    gemm_tile([&](int i, int r, int k) { return *(const bf16x8*)(Ab + (size_t)r * lda + k); },
              [&](int i, int r, int k) { return *(const bf16x8*)(Bb + (size_t)r * K + k); }, K / 64,
              [&](f32x4(&acc)[4][4], int r0, int c0) {
#pragma unroll
                for (int m = 0; m < 4; ++m)
#pragma unroll
                  for (int n = 0; n < 4; ++n) {
                    size_t idx = (size_t)(mt * 128 + r0 + m * 16) * 1024 + nt * 128 + c0 + n * 4;
                    float4 base = FIRST ? *(const float4*)(p.x + idx) : *(const float4*)(p.out + idx);
                    float4 g4 = *(const float4*)(gt + c0 + n * 4);
                    base.x += g4.x * acc[m][n][0];
                    base.y += g4.y * acc[m][n][1];
                    base.z += g4.z * acc[m][n][2];
                    base.w += g4.w * acc[m][n][3];
                    *(float4*)(p.out + idx) = base;
                  }
              },
              smem);
  }
}

__device__ __forceinline__ void ph_conv(const P& p, int bid, int nb) {
  const bf16_t* proj = (const bf16_t*)(p.ws + OFF_PROJ);
  bf16_t* xc = (bf16_t*)p.out;
  for (int idx = bid * 256 + threadIdx.x; idx < T * 192; idx += nb * 256) {
    int t = idx / 192, c0 = (idx % 192) * 8, tl = t & (SEQ - 1);
    float acc[8];
#pragma unroll
    for (int j = 0; j < 8; ++j) acc[j] = p.conv_b[c0 + j];
#pragma unroll
    for (int jj = 0; jj < 4; ++jj) {
      if (tl - 3 + jj >= 0) {
        bf16x8 v = *(const bf16x8*)(proj + (size_t)(t - 3 + jj) * NPROJ + 5120 + c0);
#pragma unroll
        for (int j = 0; j < 8; ++j) acc[j] += p.conv_w[jj * 1536 + c0 + j] * bfs2f(v[j]);
      }
    }
    bf16x8 o;
#pragma unroll
    for (int j = 0; j < 8; ++j) o[j] = (short)f2bf(siluf_(acc[j]));
    *(bf16x8*)(xc + (size_t)t * 1536 + c0) = o;
  }
}

__device__ __forceinline__ void ph_scan0(const P& p, int bid, int nb, char* smem) {
  const bf16_t* proj = (const bf16_t*)(p.ws + OFF_PROJ);
  const bf16_t* xc = (const bf16_t*)p.out;
  bf16_t* o = (bf16_t*)(p.ws + OFF_S2);
  const float* lb = (const float*)(p.ws + OFF_LB);
  const float* dt = (const float*)(p.ws + OFF_DT);
  const int tid = threadIdx.x;
  for (int u = bid; u < 96; u += nb) {
    if (u < 32) {
      const int b = u >> 3, h = u & 7;
      float* qs = (float*)smem;
      float* fs = qs + 2048;
      float* vs = fs + 2048;
      const int v = tid >> 1, half = tid & 1;
      float S[64];
#pragma unroll
      for (int k = 0; k < 64; ++k) S[k] = 0.f;
      const int st_l = tid >> 4, k0_l = (tid & 15) * 8;
      float lbv[8];
#pragma unroll
      for (int j = 0; j < 8; ++j) lbv[j] = lb[h * 128 + k0_l + j];
      for (int t0 = 0; t0 < SEQ; t0 += 16) {
        __syncthreads();
        {
          const bf16_t* row = proj + (size_t)(b * SEQ + t0 + st_l) * NPROJ + h * 128 + k0_l;
          bf16x8 q8 = *(const bf16x8*)row, f8 = *(const bf16x8*)(row + 1024), i8 = *(const bf16x8*)(row + 2048);
#pragma unroll
          for (int j = 0; j < 8; ++j) {
            qs[st_l * 128 + k0_l + j] = bfs2f(q8[j]);
            fs[st_l * 128 + k0_l + j] = lbv[j] + (1.f - lbv[j]) * sigmoidf_(bfs2f(f8[j]));
            vs[st_l * 128 + k0_l + j] = bfs2f(i8[j]);
          }
        }
        __syncthreads();
        for (int st = 0; st < 16; ++st) {
          float vv = vs[st * 128 + v];
          float oo = 0.f;
          const float4* f4 = (const float4*)(fs + st * 128 + half * 64);
          const float4* q4 = (const float4*)(qs + st * 128 + half * 64);
#pragma unroll
          for (int kq = 0; kq < 16; ++kq) {
            float4 f = f4[kq], q = q4[kq];
            S[kq * 4 + 0] = f.x * S[kq * 4 + 0] + (1.f - f.x) * vv;
            oo += S[kq * 4 + 0] * q.x;
            S[kq * 4 + 1] = f.y * S[kq * 4 + 1] + (1.f - f.y) * vv;
            oo += S[kq * 4 + 1] * q.y;
            S[kq * 4 + 2] = f.z * S[kq * 4 + 2] + (1.f - f.z) * vv;
            oo += S[kq * 4 + 2] * q.z;
            S[kq * 4 + 3] = f.w * S[kq * 4 + 3] + (1.f - f.w) * vv;
            oo += S[kq * 4 + 3] * q.w;
          }
          oo += __shfl_xor(oo, 1, 64);
          if (half == 0) o[(size_t)(b * SEQ + t0 + st) * 2048 + h * 128 + v] = f2bf(oo);
        }
      }
    } else {
      const int uu = u - 32, b = uu >> 4, hd = uu & 15, g = hd >> 3;
      float* Bs = (float*)smem;
      float* Cs = Bs + 2048;
      float* xs = Cs + 2048;
      float* zs = xs + 1024;
      float* dts = zs + 1024;
      const int pp = tid >> 2, qd = tid & 3;
      float hh[32];
#pragma unroll
      for (int n = 0; n < 32; ++n) hh[n] = 0.f;
      const float a = -__expf(p.a_log[hd]);
      const float dsk = p.d_skip[hd];
      const int st_l = tid >> 4, n0_l = (tid & 15) * 8;
      for (int t0 = 0; t0 < SEQ; t0 += 16) {
        __syncthreads();
        {
          const size_t tt = (size_t)(b * SEQ + t0 + st_l);
          bf16x8 b8 = *(const bf16x8*)(xc + tt * 1536 + 1024 + g * 128 + n0_l);
          bf16x8 c8 = *(const bf16x8*)(xc + tt * 1536 + 1280 + g * 128 + n0_l);
#pragma unroll
          for (int j = 0; j < 8; ++j) {
            Bs[st_l * 128 + n0_l + j] = bfs2f(b8[j]);
            Cs[st_l * 128 + n0_l + j] = bfs2f(c8[j]);
          }
          if (tid < 128) {
            int st2 = tid >> 3, p0 = (tid & 7) * 8;
            const size_t t2 = (size_t)(b * SEQ + t0 + st2);
            bf16x8 x8 = *(const bf16x8*)(xc + t2 * 1536 + hd * 64 + p0);
            bf16x8 z8 = *(const bf16x8*)(proj + t2 * NPROJ + 4096 + hd * 64 + p0);
#pragma unroll
            for (int j = 0; j < 8; ++j) {
              xs[st2 * 64 + p0 + j] = bfs2f(x8[j]);
              zs[st2 * 64 + p0 + j] = bfs2f(z8[j]);
            }
          }
          if (tid < 16) dts[tid] = dt[(size_t)(b * SEQ + t0 + tid) * 16 + hd];
        }
        __syncthreads();
        for (int st = 0; st < 16; ++st) {
          float dtt = dts[st];
          float dA = __expf(dtt * a);
          float xv = xs[st * 64 + pp];
          float coef = dtt * xv;
          float y = 0.f;
          const float4* B4 = (const float4*)(Bs + st * 128 + qd * 32);
          const float4* C4 = (const float4*)(Cs + st * 128 + qd * 32);
#pragma unroll
          for (int nq = 0; nq < 8; ++nq) {
            float4 bb = B4[nq], cc = C4[nq];
            hh[nq * 4 + 0] = dA * hh[nq * 4 + 0] + coef * bb.x;
            y += cc.x * hh[nq * 4 + 0];
            hh[nq * 4 + 1] = dA * hh[nq * 4 + 1] + coef * bb.y;
            y += cc.y * hh[nq * 4 + 1];
            hh[nq * 4 + 2] = dA * hh[nq * 4 + 2] + coef * bb.z;
            y += cc.z * hh[nq * 4 + 2];
            hh[nq * 4 + 3] = dA * hh[nq * 4 + 3] + coef * bb.w;
            y += cc.w * hh[nq * 4 + 3];
          }
          y += __shfl_xor(y, 1, 64);
          y += __shfl_xor(y, 2, 64);
          if (qd == 0) {
            y += dsk * xv;
            o[(size_t)(b * SEQ + t0 + st) * 2048 + 1024 + hd * 64 + pp] = f2bf(y * siluf_(zs[st * 64 + pp]));
          }
        }
      }
    }
  }
}

__device__ __forceinline__ void ph_norms0(const P& p, int bid, int nb) {
  const int lane = threadIdx.x & 63, wid = threadIdx.x >> 6;
  bf16_t* o = (bf16_t*)(p.ws + OFF_S2);
  const bf16_t* proj = (const bf16_t*)(p.ws + OFF_PROJ);
  for (int t = bid * 4 + wid; t < T; t += nb * 4) {
    bf16_t* row = o + (size_t)t * 2048 + lane * 32;
    float v[32];
    float ss = 0.f;
#pragma unroll
    for (int i = 0; i < 4; ++i) {
      bf16x8 x8 = *(const bf16x8*)(row + i * 8);
#pragma unroll
      for (int j = 0; j < 8; ++j) {
        v[i * 8 + j] = bfs2f(x8[j]);
        ss += v[i * 8 + j] * v[i * 8 + j];
      }
    }
    ss += __shfl_xor(ss, 1, 64);
    ss += __shfl_xor(ss, 2, 64);
    float s16 = ss;
    s16 += __shfl_xor(s16, 4, 64);
    s16 += __shfl_xor(s16, 8, 64);
    const bool isA = lane < 32;
    float rstd = isA ? rsqrtf(ss * (1.f / 128.f) + 1e-6f) : rsqrtf(s16 * (1.f / 512.f) + 1e-6f);
    const int c0 = isA ? lane * 32 : lane * 32 - 1024;
    const float* nw = isA ? p.hg_norm + c0 : p.ssm_norm + c0;
    const bf16_t* grow = proj + (size_t)t * NPROJ + 3072 + (isA ? c0 : 0);
#pragma unroll
    for (int i = 0; i < 4; ++i) {
      bf16x8 g8 = *(const bf16x8*)(grow + i * 8);
      bf16x8 o8;
#pragma unroll
      for (int j = 0; j < 8; ++j) {
        float val = v[i * 8 + j] * rstd * nw[i * 8 + j];
        if (isA) val *= siluf_(bfs2f(g8[j]));
        o8[j] = (short)f2bf(val);
      }
      *(bf16x8*)(row + i * 8) = o8;
    }
  }
}

__device__ __forceinline__ void ph_route(const P& p, int layer, int bid, int nb) {
  const int lane = threadIdx.x & 63, wid = threadIdx.x >> 6;
  const float* mod = (const float*)(p.ws + OFF_MOD);
  bf16_t* hbf = (bf16_t*)(p.ws + OFF_S1);
  int* cnt = (int*)(p.ws + OFF_CNT) + layer * 32;
  int* list = (int*)(p.ws + OFF_LIST);
  float* gates = (float*)(p.ws + OFF_GATES);
  for (int t = bid * 4 + wid; t < T; t += nb * 4) {
    int b = t >> 12;
    const float* m0 = mod + (size_t)(layer * 4 + b) * 6144;
    float h[16];
    row_norm_mod(p.out + (size_t)t * 1024, p.norm_w + (layer * 2 + 1) * 1024, m0 + 3072, m0 + 4096, lane, h);
    store_hbf(hbf + (size_t)t * 1024, lane, h);
    float lg[16];
#pragma unroll
    for (int j = 0; j < 16; ++j) lg[j] = 0.f;
#pragma unroll
    for (int i = 0; i < 4; ++i) {
#pragma unroll
      for (int j = 0; j < 4; ++j) {
        int d = (lane + 64 * i) * 4 + j;
        const float4* wd = (const float4*)(p.router_w + (size_t)d * 16);
        float hv = h[i * 4 + j];
#pragma unroll
        for (int q = 0; q < 4; ++q) {
          float4 w4 = wd[q];
          lg[q * 4 + 0] += hv * w4.x;
          lg[q * 4 + 1] += hv * w4.y;
          lg[q * 4 + 2] += hv * w4.z;
          lg[q * 4 + 3] += hv * w4.w;
        }
      }
    }
    float mx = -1e30f;
#pragma unroll
    for (int j = 0; j < 16; ++j) {
      lg[j] = wave_sum(lg[j]) + p.router_b[j];
      mx = fmaxf(mx, lg[j]);
    }
    float sum = 0.f;
#pragma unroll
    for (int j = 0; j < 16; ++j) {
      lg[j] = __expf(lg[j] - mx);
      sum += lg[j];
    }
    float inv = 1.f / sum;
#pragma unroll
    for (int j = 0; j < 16; ++j) lg[j] *= inv;
    int best = 0;
    float bests = -1.f;
    float q0 = 0, q1 = 0, q2 = 0, q3 = 0;
#pragma unroll
    for (int g = 0; g < 4; ++g) {
      float a0 = lg[g * 4], a1 = lg[g * 4 + 1], a2 = lg[g * 4 + 2], a3 = lg[g * 4 + 3];
      float hi01 = fmaxf(a0, a1), lo01 = fminf(a0, a1), hi23 = fmaxf(a2, a3), lo23 = fminf(a2, a3);
      float m1 = fmaxf(hi01, hi23);
      float m2 = fmaxf(fminf(hi01, hi23), fmaxf(lo01, lo23));
      float s = m1 + m2;
      if (s > bests) {
        bests = s;
        best = g;
        q0 = a0;
        q1 = a1;
        q2 = a2;
        q3 = a3;
      }
    }
    int i1 = 0;
    float v1 = q0;
    if (q1 > v1) { v1 = q1; i1 = 1; }
    if (q2 > v1) { v1 = q2; i1 = 2; }
    if (q3 > v1) { v1 = q3; i1 = 3; }
    int i2 = -1;
    float v2 = -1.f;
    if (i1 != 0 && q0 > v2) { v2 = q0; i2 = 0; }
    if (i1 != 1 && q1 > v2) { v2 = q1; i2 = 1; }
    if (i1 != 2 && q2 > v2) { v2 = q2; i2 = 2; }
    if (i1 != 3 && q3 > v2) { v2 = q3; i2 = 3; }
    float wsum = v1 + v2;
    float g1 = v1 / wsum, g2 = v2 / wsum;
    int lo = i1 < i2 ? i1 : i2, hi = i1 < i2 ? i2 : i1;
    float glo = i1 < i2 ? g1 : g2, ghi = i1 < i2 ? g2 : g1;
    int pidx = (lo == 0) ? (hi - 1) : ((lo == 1) ? (hi + 1) : 5);
    int combo = best * 6 + pidx;
    if (lane == 0) {
      int slot = atomicAdd(&cnt[combo], 1);
      list[(size_t)combo * T + slot] = t;
      gates[(size_t)t * 2] = glo;
      gates[(size_t)t * 2 + 1] = ghi;
    }
  }
}

struct MoeMap {
  int pre[25];
};
__device__ __forceinline__ void moe_find(const int* cnt, int tg, int& combo, int& mt, int& n, int& sbase) {
  int acc = 0;
  combo = 0;
  mt = 0;
  n = 0;
  sbase = 0;
  bool found = false;
  for (int c = 0; c < 24; ++c) {
    int cc = cnt[c];
    int nt = (cc + 127) >> 7;
    if (!found && tg < acc + nt) {
      combo = c;
      mt = tg - acc;
      n = cc;
      sbase = acc * 128;
      found = true;
    }
    acc += nt;
  }
}
__device__ __forceinline__ int moe_total_tiles(const int* cnt) {
  int acc = 0;
  for (int c = 0; c < 24; ++c) acc += (cnt[c] + 127) >> 7;
  return acc;
}
__device__ __forceinline__ void combo_experts(int combo, int& e1, int& e2) {
  int g = combo / 6, pi = combo % 6;
  int lo = pi < 3 ? 0 : (pi < 5 ? 1 : 2);
  int hi = pi < 3 ? pi + 1 : (pi < 5 ? pi - 1 : 3);
  e1 = g * 4 + lo;
  e2 = g * 4 + hi;
}

__device__ __forceinline__ void ph_moe_up(const P& p, int layer, int bid, int nb, char* smem) {
  const int* cnt = (const int*)(p.ws + OFF_CNT) + layer * 32;
  const int* list = (const int*)(p.ws + OFF_LIST);
  const float* gates = (const float*)(p.ws + OFF_GATES);
  const bf16_t* hbf = (const bf16_t*)(p.ws + OFF_S1);
  const bf16_t* W13 = (const bf16_t*)(p.ws + OFF_W13T);
  bf16_t* hid = (bf16_t*)(p.ws + OFF_HID);
  const int TT = moe_total_tiles(cnt);
  const int tid = threadIdx.x;
  for (int w = bid; w < TT * 16; w += nb) {
    int tg = w >> 4, nt = w & 15;
    int combo, mt, n, sbase;
    moe_find(cnt, tg, combo, mt, n, sbase);
    int e1, e2;
    combo_experts(combo, e1, e2);
    const int e = nt < 8 ? e1 : e2;
    const int* lst = list + (size_t)combo * T;
    const bf16_t* Bb = W13 + (size_t)e * 1048576 + (size_t)(nt & 7) * 128 * 1024;
    const bf16_t* arow[4];
#pragma unroll
    for (int i = 0; i < 4; ++i) {
      int slot = mt * 128 + (tid >> 3) + 32 * i;
      int tok = lst[slot < n ? slot : 0];
      arow[i] = hbf + (size_t)tok * 1024;
    }
    gemm_tile([&](int i, int r, int k) { return *(const bf16x8*)(arow[i] + k); },
              [&](int i, int r, int k) { return *(const bf16x8*)(Bb + (size_t)r * 1024 + k); }, 16,
              [&](f32x4(&acc)[4][4], int r0, int c0) {
                const int wc = c0 >> 6, fq = (c0 >> 4) & 3;
                const int hc = (nt >> 3) * 512 + (nt & 7) * 64 + wc * 32 + fq * 8;
#pragma unroll
                for (int m = 0; m < 4; ++m) {
                  int slot = mt * 128 + r0 + m * 16;
                  int tok = lst[slot < n ? slot : 0];
                  float gate = gates[(size_t)tok * 2 + (nt >> 3)];
                  bf16x8 o8;
#pragma unroll
                  for (int np = 0; np < 2; ++np)
#pragma unroll
                    for (int j = 0; j < 4; ++j)
                      o8[np * 4 + j] = (short)f2bf(siluf_(acc[m][2 * np][j]) * acc[m][2 * np + 1][j] * gate);
                  *(bf16x8*)(hid + (size_t)(sbase + slot) * 1024 + hc) = o8;
                }
              },
              smem);
  }
}

__device__ __forceinline__ void ph_moe_down(const P& p, int layer, int bid, int nb, char* smem) {
  const int* cnt = (const int*)(p.ws + OFF_CNT) + layer * 32;
  const int* list = (const int*)(p.ws + OFF_LIST);
  const float* mod = (const float*)(p.ws + OFF_MOD);
  const bf16_t* W2 = (const bf16_t*)(p.ws + OFF_W2T);
  const bf16_t* hid = (const bf16_t*)(p.ws + OFF_HID);
  const int TT = moe_total_tiles(cnt);
  for (int w = bid; w < TT * 8; w += nb) {
    int tg = w >> 3, nt = w & 7;
    int combo, mt, n, sbase;
    moe_find(cnt, tg, combo, mt, n, sbase);
    int e1, e2;
    combo_experts(combo, e1, e2);
    const int* lst = list + (size_t)combo * T;
    const bf16_t* Ab = hid + (size_t)(sbase + mt * 128) * 1024;
    const bf16_t* B1 = W2 + (size_t)e1 * 524288 + (size_t)nt * 128 * 512;
    const bf16_t* B2 = W2 + (size_t)e2 * 524288 + (size_t)nt * 128 * 512;
    gemm_tile([&](int i, int r, int k) { return *(const bf16x8*)(Ab + (size_t)r * 1024 + k); },
              [&](int i, int r, int k) {
                return k < 512 ? *(const bf16x8*)(B1 + (size_t)r * 512 + k)
                               : *(const bf16x8*)(B2 + (size_t)r * 512 + (k - 512));
              },
              16,
              [&](f32x4(&acc)[4][4], int r0, int c0) {
#pragma unroll
                for (int m = 0; m < 4; ++m) {
                  int slot = mt * 128 + r0 + m * 16;
                  if (slot < n) {
                    int tok = lst[slot];
                    const float* gt = mod + (size_t)(layer * 4 + (tok >> 12)) * 6144 + 5120 + nt * 128 + c0;
                    float* orow = p.out + (size_t)tok * 1024 + nt * 128 + c0;
#pragma unroll
                    for (int nn = 0; nn < 4; ++nn) {
                      float4 base = *(const float4*)(orow + nn * 4);
                      float4 g4 = *(const float4*)(gt + nn * 4);
                      base.x += g4.x * acc[m][nn][0];
                      base.y += g4.y * acc[m][nn][1];
                      base.z += g4.z * acc[m][nn][2];
                      base.w += g4.w * acc[m][nn][3];
                      *(float4*)(orow + nn * 4) = base;
                    }
                  }
                }
              },
              smem);
  }
}

__device__ __forceinline__ void ph_norm1(const P& p, int bid, int nb) {
  const int lane = threadIdx.x & 63, wid = threadIdx.x >> 6;
  const float* mod = (const float*)(p.ws + OFF_MOD);
  bf16_t* hbf = (bf16_t*)(p.ws + OFF_S1);
  bf16_t* mx0 = (bf16_t*)(p.ws + OFF_KK);
  bf16_t* mx1 = (bf16_t*)(p.ws + OFF_AA);
  bf16_t* mx2 = (bf16_t*)(p.ws + OFF_G);
  for (int ch = bid * 4 + wid; ch < T / 8; ch += nb * 4) {
    const int t0 = ch * 8, b = t0 >> 12;
    const float* m0 = mod + (size_t)(1 * 4 + b) * 6144;
    float hp[16];
    if (t0 & (SEQ - 1)) {
      row_norm_mod(p.out + (size_t)(t0 - 1) * 1024, p.norm_w + 2 * 1024, m0, m0 + 1024, lane, hp);
    } else {
#pragma unroll
      for (int j = 0; j < 16; ++j) hp[j] = 0.f;
    }
    for (int tt = 0; tt < 8; ++tt) {
      const int t = t0 + tt;
      float h[16];
      row_norm_mod(p.out + (size_t)t * 1024, p.norm_w + 2 * 1024, m0, m0 + 1024, lane, h);
      store_hbf(hbf + (size_t)t * 1024, lane, h);
#pragma unroll
      for (int i = 0; i < 4; ++i) {
        const int d0 = (lane + 64 * i) * 4;
        float4 mu0 = *(const float4*)(p.mu + d0), mu1 = *(const float4*)(p.mu + 1024 + d0),
               mu2 = *(const float4*)(p.mu + 2048 + d0);
        float x0 = hp[i * 4] - h[i * 4], x1 = hp[i * 4 + 1] - h[i * 4 + 1], x2 = hp[i * 4 + 2] - h[i * 4 + 2],
              x3 = hp[i * 4 + 3] - h[i * 4 + 3];
        *(uint2*)(mx0 + (size_t)t * 1024 + d0) = pack4(h[i * 4] + x0 * mu0.x, h[i * 4 + 1] + x1 * mu0.y,
                                                       h[i * 4 + 2] + x2 * mu0.z, h[i * 4 + 3] + x3 * mu0.w);
        *(uint2*)(mx1 + (size_t)t * 1024 + d0) = pack4(h[i * 4] + x0 * mu1.x, h[i * 4 + 1] + x1 * mu1.y,
                                                       h[i * 4 + 2] + x2 * mu1.z, h[i * 4 + 3] + x3 * mu1.w);
        *(uint2*)(mx2 + (size_t)t * 1024 + d0) = pack4(h[i * 4] + x0 * mu2.x, h[i * 4 + 1] + x1 * mu2.y,
                                                       h[i * 4 + 2] + x2 * mu2.z, h[i * 4 + 3] + x3 * mu2.w);
      }
#pragma unroll
      for (int j = 0; j < 16; ++j) hp[j] = h[j];
    }
  }
}

__device__ __forceinline__ void ph_gemm_rkv(const P& p, int bid, int nb, char* smem) {
  const bf16_t* hbf = (const bf16_t*)(p.ws + OFF_S1);
  const bf16_t* W = (const bf16_t*)(p.ws + OFF_WRKVT);
  const bf16_t* L1T = (const bf16_t*)(p.ws + OFF_LORA1T);
  bf16_t* lora1 = (bf16_t*)(p.ws + OFF_LORA1);
  for (int w = bid; w < 128 * 26; w += nb) {
    int mt = w % 128, nt = w / 128;
    const int m0 = mt * 128;
    if (nt < 24) {
      const int wi = nt >> 3, n0 = (nt & 7) * 128;
      const bf16_t* Bb = W + (size_t)wi * 1048576 + (size_t)n0 * 1024;
      bf16_t* C = (bf16_t*)(p.ws + OFF_R + (size_t)wi * 32 * MiB);
      const bf16_t* Ab = (const bf16_t*)(p.ws + OFF_KK + (size_t)wi * 32 * MiB) + (size_t)m0 * 1024;
      gemm_tile(
          [&](int i, int r, int k) { return *(const bf16x8*)(Ab + (size_t)r * 1024 + k); },
          [&](int i, int r, int k) { return *(const bf16x8*)(Bb + (size_t)r * 1024 + k); }, 16,
          [&](f32x4(&acc)[4][4], int r0, int c0) {
#pragma unroll
            for (int m = 0; m < 4; ++m) store16(C + (size_t)(m0 + r0 + m * 16) * 1024 + n0 + c0, acc[m]);
          },
          smem);
    } else {
      const int n0 = (nt - 24) * 128;
      const bf16_t* Bb = L1T + (size_t)n0 * 2048;
      gemm_tile(
          [&](int i, int r, int k) {
            int t = m0 + r;
            if (k < 1024) return *(const bf16x8*)(hbf + (size_t)t * 1024 + k);
            bf16x8 prv = (bf16x8){0, 0, 0, 0, 0, 0, 0, 0};
            if (t & (SEQ - 1)) prv = *(const bf16x8*)(hbf + (size_t)(t - 1) * 1024 + (k - 1024));
            return prv;
          },
          [&](int i, int r, int k) { return *(const bf16x8*)(Bb + (size_t)r * 2048 + k); }, 32,
          [&](f32x4(&acc)[4][4], int r0, int c0) {
            const int colb = n0 + c0;
#pragma unroll
            for (int m = 0; m < 4; ++m) {
#pragma unroll
              for (int n = 0; n < 4; ++n)
#pragma unroll
                for (int j = 0; j < 4; ++j) {
                  float v = acc[m][n][j];
                  acc[m][n][j] = colb < 64 ? tanhf(v) : (colb < 128 ? v : sigmoidf_(v));
                }
              store16(lora1 + (size_t)(m0 + r0 + m * 16) * 256 + colb, acc[m]);
            }
          },
          smem);
    }
  }
}

__device__ __forceinline__ void ph_gemm_lora2(const P& p, int bid, int nb, char* smem) {
  const bf16_t* lora1 = (const bf16_t*)(p.ws + OFF_LORA1);
  float* wdec = (float*)(p.ws + OFF_S2);
  bf16_t* aa = (bf16_t*)(p.ws + OFF_AA);
  bf16_t* gg = (bf16_t*)(p.ws + OFF_G);
  for (int w = bid; w < 128 * 24; w += nb) {
    int mt = w % 128, rest = w / 128, which = rest >> 3, nt = rest & 7;
    const int m0 = mt * 128, n0 = nt * 128;
    const int K = which == 2 ? 128 : 64;
    const int aoff = which == 0 ? 0 : (which == 1 ? 64 : 128);
    const bf16_t* Bt = (const bf16_t*)(p.ws + (which == 0 ? OFF_DEC2T : (which == 1 ? OFF_A2T : OFF_G2T)));
    const bf16_t* Ab = lora1 + (size_t)m0 * 256 + aoff;
    const bf16_t* Bb = Bt + (size_t)n0 * K;
    gemm_tile([&](int i, int r, int k) { return *(const bf16x8*)(Ab + (size_t)r * 256 + k); },
              [&](int i, int r, int k) { return *(const bf16x8*)(Bb + (size_t)r * K + k); }, K / 64,
              [&](f32x4(&acc)[4][4], int r0, int c0) {
#pragma unroll
                for (int m = 0; m < 4; ++m) {
                  const int col = n0 + c0;
                  const size_t idx = (size_t)(m0 + r0 + m * 16) * 1024 + col;
                  if (which == 0) {
#pragma unroll
                    for (int n = 0; n < 4; ++n) {
                      float4 o;
                      float* op = (float*)&o;
#pragma unroll
                      for (int j = 0; j < 4; ++j) {
                        float wl = -softplusf_(-(p.dec0[col + n * 4 + j] + acc[m][n][j])) - 0.5f;
                        op[j] = __expf(-__expf(wl));
                      }
                      *(float4*)(wdec + idx + n * 4) = o;
                    }
                  } else if (which == 1) {
#pragma unroll
                    for (int n = 0; n < 4; ++n)
#pragma unroll
                      for (int j = 0; j < 4; ++j) acc[m][n][j] = sigmoidf_(p.a0[col + n * 4 + j] + acc[m][n][j]);
                    store16(aa + idx, acc[m]);
                  } else {
                    store16(gg + idx, acc[m]);
                  }
                }
              },
              smem);
  }
}

__device__ __forceinline__ void ph_prep1(const P& p, int bid, int nb) {
  const int lane = threadIdx.x & 63, wid = threadIdx.x >> 6;
  const bf16_t* R = (const bf16_t*)(p.ws + OFF_R);
  bf16_t* Kb = (bf16_t*)(p.ws + OFF_K);
  bf16_t* KK = (bf16_t*)(p.ws + OFF_KK);
  const bf16_t* AA = (const bf16_t*)(p.ws + OFF_AA);
  float* bonus = (float*)(p.ws + OFF_BONUS);
  const int c0 = lane * 16;
  for (int t = bid * 4 + wid; t < T; t += nb * 4) {
    size_t base = (size_t)t * 1024 + c0;
    float kv[16], av[16], rv[16];
#pragma unroll
    for (int i = 0; i < 2; ++i) {
      bf16x8 k8 = *(const bf16x8*)(Kb + base + i * 8), a8 = *(const bf16x8*)(AA + base + i * 8),
             r8 = *(const bf16x8*)(R + base + i * 8);
#pragma unroll
      for (int j = 0; j < 8; ++j) {
        kv[i * 8 + j] = bfs2f(k8[j]);
        av[i * 8 + j] = bfs2f(a8[j]);
        rv[i * 8 + j] = bfs2f(r8[j]);
      }
    }
    float kkv[16], kh[16];
    float ss = 0.f, bon = 0.f;
#pragma unroll
    for (int j = 0; j < 16; ++j) {
      kkv[j] = kv[j] * p.k_k[c0 + j];
      ss += kkv[j] * kkv[j];
      kh[j] = kv[j] * (1.f + (av[j] - 1.f) * p.k_a[c0 + j]);
      bon += rv[j] * kh[j] * p.r_k[c0 + j];
    }
    ss += __shfl_xor(ss, 1, 64);
    ss += __shfl_xor(ss, 2, 64);
    bon += __shfl_xor(bon, 1, 64);
    bon += __shfl_xor(bon, 2, 64);
    float inv = 1.f / fmaxf(sqrtf(ss), 1e-12f);
#pragma unroll
    for (int i = 0; i < 2; ++i) {
      bf16x8 o1, o2;
#pragma unroll
      for (int j = 0; j < 8; ++j) {
        o1[j] = (short)f2bf(kkv[i * 8 + j] * inv);
        o2[j] = (short)f2bf(kh[i * 8 + j]);
      }
      *(bf16x8*)(KK + base + i * 8) = o1;
      *(bf16x8*)(Kb + base + i * 8) = o2;
    }
    if ((lane & 3) == 0) bonus[(size_t)t * 16 + (lane >> 2)] = bon;
  }
}

__device__ __forceinline__ void ph_scan1(const P& p, int bid, int nb, char* smem) {
  bf16_t* R = (bf16_t*)(p.ws + OFF_R);
  const bf16_t* Kb = (const bf16_t*)(p.ws + OFF_K);
  const bf16_t* V = (const bf16_t*)(p.ws + OFF_V);
  const bf16_t* KK = (const bf16_t*)(p.ws + OFF_KK);
  const bf16_t* AA = (const bf16_t*)(p.ws + OFF_AA);
  const float* W = (const float*)(p.ws + OFF_S2);
  const int tid = threadIdx.x;
  float* rs = (float*)smem;
  float* ws_ = rs + 1024;
  float* ks = ws_ + 1024;
  float* ns = ks + 1024;
  float* bs = ns + 1024;
  float* vs = bs + 1024;
  for (int u = bid; u < 64; u += nb) {
    const int b = u >> 4, hd = u & 15;
    const int vr = tid >> 2, qd = tid & 3;
    float S[16];
#pragma unroll
    for (int k = 0; k < 16; ++k) S[k] = 0.f;
    const int st_l = tid >> 4, k0_l = (tid & 15) * 4;
    for (int t0 = 0; t0 < SEQ; t0 += 16) {
      __syncthreads();
      {
        size_t base = (size_t)(b * SEQ + t0 + st_l) * 1024 + hd * 64 + k0_l;
        bf16x4 r4 = *(const bf16x4*)(R + base), k4 = *(const bf16x4*)(Kb + base), v4 = *(const bf16x4*)(V + base),
               kk4 = *(const bf16x4*)(KK + base), a4 = *(const bf16x4*)(AA + base);
        float4 w4 = *(const float4*)(W + base);
        float ww[4] = {w4.x, w4.y, w4.z, w4.w};
#pragma unroll
        for (int j = 0; j < 4; ++j) {
          int li = st_l * 64 + k0_l + j;
          float kkf = bfs2f(kk4[j]);
          rs[li] = bfs2f(r4[j]);
          ws_[li] = ww[j];
          ks[li] = bfs2f(k4[j]);
          ns[li] = -kkf;
          bs[li] = kkf * bfs2f(a4[j]);
          vs[li] = bfs2f(v4[j]);
        }
      }
      __syncthreads();
      for (int st = 0; st < 16; ++st) {
        const int o = st * 64 + qd * 16;
        float vv = vs[st * 64 + vr];
        float sa = 0.f;
#pragma unroll
        for (int k = 0; k < 16; ++k) sa += S[k] * ns[o + k];
        sa += __shfl_xor(sa, 1, 64);
        sa += __shfl_xor(sa, 2, 64);
        float y = 0.f;
#pragma unroll
        for (int k = 0; k < 16; ++k) {
          S[k] = S[k] * ws_[o + k] + sa * bs[o + k] + vv * ks[o + k];
          y += S[k] * rs[o + k];
        }
        y += __shfl_xor(y, 1, 64);
        y += __shfl_xor(y, 2, 64);
        if (qd == 0) R[(size_t)(b * SEQ + t0 + st) * 1024 + hd * 64 + vr] = f2bf(y);
      }
    }
  }
}

__device__ __forceinline__ void ph_post1(const P& p, int bid, int nb) {
  const int lane = threadIdx.x & 63, wid = threadIdx.x >> 6;
  const bf16_t* Y = (const bf16_t*)(p.ws + OFF_R);
  const bf16_t* V = (const bf16_t*)(p.ws + OFF_V);
  const bf16_t* G = (const bf16_t*)(p.ws + OFF_G);
  const float* bonus = (const float*)(p.ws + OFF_BONUS);
  bf16_t* o = (bf16_t*)(p.ws + OFF_S1);
  const int c0 = lane * 16;
  for (int t = bid * 4 + wid; t < T; t += nb * 4) {
    size_t base = (size_t)t * 1024 + c0;
    float yv[16], vv[16], gv[16];
    float s = 0.f;
#pragma unroll
    for (int i = 0; i < 2; ++i) {
      bf16x8 y8 = *(const bf16x8*)(Y + base + i * 8), v8 = *(const bf16x8*)(V + base + i * 8),
             g8 = *(const bf16x8*)(G + base + i * 8);
#pragma unroll
      for (int j = 0; j < 8; ++j) {
        yv[i * 8 + j] = bfs2f(y8[j]);
        vv[i * 8 + j] = bfs2f(v8[j]);
        gv[i * 8 + j] = bfs2f(g8[j]);
        s += yv[i * 8 + j];
      }
    }
    s += __shfl_xor(s, 1, 64);
    s += __shfl_xor(s, 2, 64);
    float mean = s * (1.f / 64.f);
    float var = 0.f;
#pragma unroll
    for (int j = 0; j < 16; ++j) var += (yv[j] - mean) * (yv[j] - mean);
    var += __shfl_xor(var, 1, 64);
    var += __shfl_xor(var, 2, 64);
    float rstd = rsqrtf(var * (1.f / 64.f) + 64e-5f);
    float bon = bonus[(size_t)t * 16 + (lane >> 2)];
#pragma unroll
    for (int i = 0; i < 2; ++i) {
      bf16x8 o8;
#pragma unroll
      for (int j = 0; j < 8; ++j) {
        int c = c0 + i * 8 + j;
        float val = (yv[i * 8 + j] - mean) * rstd * p.ln_w[c] + p.ln_b[c] + bon * vv[i * 8 + j];
        o8[j] = (short)f2bf(val * gv[i * 8 + j]);
      }
      *(bf16x8*)(o + base + i * 8) = o8;
    }
  }
}

__device__ __forceinline__ void ph_final(const P& p, int bid, int nb) {
  const int lane = threadIdx.x & 63, wid = threadIdx.x >> 6;
  for (int t = bid * 4 + wid; t < T; t += nb * 4) {
    float4* xr = (float4*)(p.out + (size_t)t * 1024);
    float4 v[4];
    float ss = 0;
#pragma unroll
    for (int i = 0; i < 4; ++i) {
      v[i] = xr[lane + 64 * i];
      ss += v[i].x * v[i].x + v[i].y * v[i].y + v[i].z * v[i].z + v[i].w * v[i].w;
    }
    ss = wave_sum(ss);
    float rstd = rsqrtf(ss * (1.f / 1024.f) + 1e-6f);
#pragma unroll
    for (int i = 0; i < 4; ++i) {
      float4 w4 = *(const float4*)(p.final_w + (lane + 64 * i) * 4);
      float4 o;
      o.x = v[i].x * rstd * w4.x;
      o.y = v[i].y * rstd * w4.y;
      o.z = v[i].z * rstd * w4.z;
      o.w = v[i].w * rstd * w4.w;
      xr[lane + 64 * i] = o;
    }
  }
}

constexpr int NPHASE = 25;
template <int PH>
__device__ __forceinline__ void run_phase(const P& p, int bid, int nb, char* smem) {
  const float* mod = (const float*)(p.ws + OFF_MOD);
  if (PH == 0) { ph_prep(p, bid, nb, smem); ph_conv_w0(p, bid, nb, smem); }
  else if (PH == 1) ph_norm0(p, bid, nb);
  else if (PH == 2) ph_gemm_inproj(p, bid, nb, smem);
  else if (PH == 3) ph_conv(p, bid, nb);
  else if (PH == 4) ph_scan0(p, bid, nb, smem);
  else if (PH == 5) ph_norms0(p, bid, nb);
  else if (PH == 6) ph_gemm_resid<true>(p, (const bf16_t*)(p.ws + OFF_S2), 2048, (const bf16_t*)(p.ws + OFF_WOUTT), 2048, mod + 2048, bid, nb, smem);
  else if (PH == 7) { ph_route(p, 0, bid, nb); ph_conv_moe(p, 0, bid, nb, smem); ph_conv_w1(p, bid, nb, smem); }
  else if (PH == 8) ph_moe_up(p, 0, bid, nb, smem);
  else if (PH == 9) ph_moe_down(p, 0, bid, nb, smem);
  else if (PH == 10) ph_norm1(p, bid, nb);
  else if (PH == 11) ph_gemm_rkv(p, bid, nb, smem);
  else if (PH == 12) ph_gemm_lora2(p, bid, nb, smem);
  else if (PH == 13) ph_prep1(p, bid, nb);
  else if (PH == 14) ph_scan1(p, bid, nb, smem);
  else if (PH == 15) ph_post1(p, bid, nb);
  else if (PH == 16) ph_gemm_resid<false>(p, (const bf16_t*)(p.ws + OFF_S1), 1024, (const bf16_t*)(p.ws + OFF_WOT), 1024, mod + 4 * 6144 + 2048, bid, nb, smem);
  else if (PH == 17) { ph_route(p, 1, bid, nb); ph_conv_moe(p, 1, bid, nb, smem); }
  else if (PH == 18) ph_moe_up(p, 1, bid, nb, smem);
  else if (PH == 19) ph_moe_down(p, 1, bid, nb, smem);
  else if (PH == 20) ph_final(p, bid, nb);
}

namespace cg = cooperative_groups;

template <int PH>
__device__ __forceinline__ void run_all(const P& p, int bid, int nb, char* smem, cg::grid_group& grid) {
  if constexpr (PH < 21) {
    run_phase<PH>(p, bid, nb, smem);
    if constexpr (PH < 20) grid.sync();
    run_all<PH + 1>(p, bid, nb, smem, grid);
  }
}

__global__ void __launch_bounds__(256, 2) mega(P p) {
  __shared__ __attribute__((aligned(16))) char smem[SMEM_BYTES];
  cg::grid_group grid = cg::this_grid();
  run_all<0>(p, blockIdx.x, gridDim.x, smem, grid);
}

extern "C" void kernel_launch(void* const* d_in, const int* in_sizes, int n_in, void* d_out, int out_size, void* d_ws,
                              size_t ws_size, hipStream_t stream) {
  P p{};
  const float** pp = (const float**)&p;
  for (int i = 0; i < 37; ++i) pp[i] = (const float*)d_in[i];
  p.out = (float*)d_out;
  p.ws = (char*)d_ws;
  if (ws_size < WS_NEED) fprintf(stderr, "workspace too small: %zu < %zu\n", ws_size, (size_t)WS_NEED);
  static int grid_blocks = 0;
  if (!grid_blocks) {
    int dev = 0, cus = 0, per_cu = 0;
    hipGetDevice(&dev);
    hipDeviceGetAttribute(&cus, hipDeviceAttributeMultiprocessorCount, dev);
    hipOccupancyMaxActiveBlocksPerMultiprocessor(&per_cu, mega, 256, 0);
    if (per_cu > 2) per_cu = 2;
    if (per_cu < 1) per_cu = 1;
    grid_blocks = cus * per_cu;
  }
  void* args[] = {&p};
  hipError_t e = hipLaunchCooperativeKernel((void*)mega, dim3(grid_blocks), dim3(256), args, 0, stream);
  if (e != hipSuccess) fprintf(stderr, "cooperative launch failed: %s (grid %d)\n", hipGetErrorString(e), grid_blocks);
}
```

```cpp
#include <hip/hip_runtime.h>
#include <hip/hip_cooperative_groups.h>
#include <stdint.h>
#include <stdio.h>

typedef unsigned short bf16_t;
typedef __attribute__((ext_vector_type(8))) short bf16x8;
typedef __attribute__((ext_vector_type(4))) short bf16x4;
typedef __attribute__((ext_vector_type(4))) float f32x4;
typedef __attribute__((ext_vector_type(2))) float f32x2;

constexpr int T = 16384;
constexpr int SEQ = 4096;
constexpr int NPROJ = 6656;

constexpr size_t MiB = 1048576;
constexpr size_t OFF_MOD = 0;
constexpr size_t OFF_LB = 196608;
constexpr size_t OFF_CNT = 200704;
constexpr size_t OFF_CNTP = 6 * (size_t)(1 << 20) + 65536;
constexpr int CNT_STRIDE = 64, CNT_LAYER = 2048;
constexpr size_t OFF_DT = 200960;
constexpr size_t OFF_GATES = OFF_DT + (size_t)T * 16 * 4;
constexpr size_t OFF_BONUS = OFF_GATES + (size_t)T * 2 * 4;
constexpr size_t OFF_LIST = OFF_BONUS + (size_t)T * 16 * 4;
constexpr size_t OFF_WA = 8 * MiB;
constexpr size_t OFF_S1 = 28 * MiB;
constexpr size_t OFF_S2 = 60 * MiB;
constexpr size_t OFF_BIG = 124 * MiB;
constexpr size_t WS_NEED = 340 * MiB;
constexpr size_t OFF_WOUTT = OFF_WA;
constexpr size_t OFF_WINT = OFF_WA + 4 * MiB;
constexpr size_t OFF_WRKVT = OFF_WA;
constexpr size_t OFF_WOT = OFF_WA + 6 * MiB;
constexpr size_t OFF_LORA1T = OFF_WA + 8 * MiB;
constexpr size_t OFF_DEC2T = OFF_WA + 9 * MiB;
constexpr size_t OFF_A2T = OFF_DEC2T + 131072;
constexpr size_t OFF_G2T = OFF_A2T + 131072;
constexpr size_t OFF_PROJ = OFF_BIG;
constexpr size_t OFF_W13T = OFF_BIG;
constexpr size_t OFF_W2T = OFF_BIG + 32 * MiB;
constexpr size_t OFF_HID = OFF_BIG + 48 * MiB;
constexpr size_t OFF_W13T_L1 = OFF_BIG + 96 * MiB;
constexpr size_t OFF_W2T_L1 = OFF_BIG + 200 * MiB;
constexpr size_t OFF_R = OFF_BIG;
constexpr size_t OFF_K = OFF_BIG + 32 * MiB;
constexpr size_t OFF_V = OFF_BIG + 64 * MiB;
constexpr size_t OFF_KK = OFF_BIG + 96 * MiB;
constexpr size_t OFF_AA = OFF_BIG + 128 * MiB;
constexpr size_t OFF_G = OFF_BIG + 160 * MiB;
constexpr size_t OFF_LORA1 = OFF_BIG + 192 * MiB;

struct P {
  const float *x, *c, *mod_w, *mod_b, *norm_w, *lb_logits, *w_in, *hg_norm, *conv_w, *conv_b, *dt_bias, *a_log,
      *d_skip, *ssm_norm, *w_out, *mu, *w_rkv, *dec0, *dec1, *dec2, *a0, *a1, *a2, *g1, *g2, *k_k, *k_a, *r_k,
      *ln_w, *ln_b, *w_o, *router_w, *router_b, *moe_w1, *moe_w3, *moe_w2, *final_w;
  float* out;
  char* ws;
};

#define PROBE_MASK 0
constexpr size_t OFF_TS = 6 * MiB;

#define LAS __attribute__((address_space(3)))
constexpr size_t OFF_BAR = 7 * MiB;
constexpr size_t OFF_CEN = OFF_BAR + 16384;
constexpr size_t BAR_MEMSET_BYTES = 16384 + 16384 + 256;

__device__ __forceinline__ int tid_fresh() {
  int t = threadIdx.x;
  asm volatile("" : "+v"(t));
  return t;
}
#define TIDX (tid_fresh() & 255)

__device__ __forceinline__ float bf2f(bf16_t h) { return __uint_as_float(((uint32_t)h) << 16); }
__device__ __forceinline__ float bfs2f(short h) { return __uint_as_float(((uint32_t)(unsigned short)h) << 16); }
typedef __attribute__((ext_vector_type(2))) float cvt_f2_t;
typedef __attribute__((ext_vector_type(2))) __bf16 cvt_bf2_t;
__device__ __forceinline__ uint32_t cvt_pk_bf16(float lo, float hi) {
  const cvt_f2_t v = {lo, hi};
  return __builtin_bit_cast(uint32_t, __builtin_convertvector(v, cvt_bf2_t));
}
__device__ __forceinline__ bf16_t f2bf(float f) { return (bf16_t)(cvt_pk_bf16(f, f) & 0xffffu); }
typedef __attribute__((ext_vector_type(4))) unsigned int u32x4_t;
__device__ __forceinline__ bf16x8 pack8(float a0, float a1, float a2, float a3, float a4, float a5, float a6, float a7) {
  u32x4_t r = {cvt_pk_bf16(a0, a1), cvt_pk_bf16(a2, a3), cvt_pk_bf16(a4, a5), cvt_pk_bf16(a6, a7)};
  return __builtin_bit_cast(bf16x8, r);
}
__device__ __forceinline__ float sigmoidf_(float x) { return __builtin_amdgcn_rcpf(1.f + __expf(-x)); }
__device__ __forceinline__ float siluf_(float x) { return x * __builtin_amdgcn_rcpf(1.f + __expf(-x)); }
__device__ __forceinline__ float softplusf_(float x) { return x > 20.f ? x : log1pf(__expf(x)); }
__device__ __forceinline__ float wave_sum(float v) {
#pragma unroll
  for (int m = 32; m >= 1; m >>= 1) v += __shfl_xor(v, m, 64);
  return v;
}
__device__ __forceinline__ uint2 pack4(float a, float b, float c, float d) {
  uint2 r;
  r.x = cvt_pk_bf16(a, b);
  r.y = cvt_pk_bf16(c, d);
  return r;
}

__device__ __forceinline__ void store16(bf16_t* dst, const f32x4 (&a)[4]) {
  const bf16x8 o0 = pack8(a[0][0], a[0][1], a[0][2], a[0][3], a[1][0], a[1][1], a[1][2], a[1][3]);
  const bf16x8 o1 = pack8(a[2][0], a[2][1], a[2][2], a[2][3], a[3][0], a[3][1], a[3][2], a[3][3]);
  *(bf16x8*)dst = o0;
  *(bf16x8*)(dst + 8) = o1;
}

constexpr int LSTR = 144;
constexpr int SMEM_BYTES = 54272;

template <class AF, class BF, class EF>
__device__ __forceinline__ void gemm_tile(AF af, BF bf, int nk, EF ef, char* smem) {
  const int tid = TIDX, lane = tid & 63, wid = tid >> 6, wr = wid >> 1, wc = wid & 1, fr = lane & 15,
            fq = lane >> 4;
  char* sA = smem;
  char* sB = smem + 128 * LSTR;
  const int lrow = tid >> 3, lkc = tid & 7;
  bf16x8 ra[4], rb[4];
  f32x4 acc[4][4];
#pragma unroll
  for (int m = 0; m < 4; ++m)
#pragma unroll
    for (int n = 0; n < 4; ++n) acc[m][n] = (f32x4){0.f, 0.f, 0.f, 0.f};
#pragma unroll
  for (int i = 0; i < 4; ++i) {
    ra[i] = af(i, lrow + 32 * i, lkc * 8);
    rb[i] = bf(i, lrow + 32 * i, lkc * 8);
  }
  for (int kt = 0; kt < nk; ++kt) {
    __syncthreads();
#pragma unroll
    for (int i = 0; i < 4; ++i) {
      *(bf16x8*)(sA + (lrow + 32 * i) * LSTR + lkc * 16) = ra[i];
      *(bf16x8*)(sB + (lrow + 32 * i) * LSTR + lkc * 16) = rb[i];
    }
    __syncthreads();
    if (kt + 1 < nk) {
#pragma unroll
      for (int i = 0; i < 4; ++i) {
        ra[i] = af(i, lrow + 32 * i, (kt + 1) * 64 + lkc * 8);
        rb[i] = bf(i, lrow + 32 * i, (kt + 1) * 64 + lkc * 8);
      }
    }
#pragma unroll
    for (int s = 0; s < 2; ++s) {
      bf16x8 a[4], b[4];
#pragma unroll
      for (int m = 0; m < 4; ++m) a[m] = *(const bf16x8*)(sA + (wr * 64 + m * 16 + fr) * LSTR + s * 64 + fq * 16);
#pragma unroll
      for (int n = 0; n < 4; ++n) b[n] = *(const bf16x8*)(sB + (wc * 64 + n * 16 + fr) * LSTR + s * 64 + fq * 16);
#pragma unroll
      for (int m = 0; m < 4; ++m)
#pragma unroll
        for (int n = 0; n < 4; ++n) acc[m][n] = __builtin_amdgcn_mfma_f32_16x16x32_bf16(b[n], a[m], acc[m][n], 0, 0, 0);
    }
  }
  ef(acc, wr * 64 + fr, wc * 64 + fq * 16);
}

__device__ __forceinline__ void ph_prep(const P& p, int bid, int nb, char* smem) {
  float* sc = (float*)smem;
  float* red = sc + 4096;
  const int tid = TIDX;
  float* mod = (float*)(p.ws + OFF_MOD);
  for (int i = tid; i < 4096; i += 256) sc[i] = siluf_(p.c[i]);
  __syncthreads();
  for (int u = bid; u < 768; u += nb) {
    const int l = u / 384, e0 = (u % 384) * 16;
    const int kq = tid >> 4, col = tid & 15;
    const int dbase = kq * 64;
    const float* w = p.mod_w + ((size_t)l * 1024 + dbase) * 6144 + e0 + col;
    float a0 = 0, a1 = 0, a2 = 0, a3 = 0;
#pragma unroll 16
    for (int d = 0; d < 64; ++d) {
      float wv = w[(size_t)d * 6144];
      int dd = dbase + d;
      a0 += sc[dd] * wv;
      a1 += sc[1024 + dd] * wv;
      a2 += sc[2048 + dd] * wv;
      a3 += sc[3072 + dd] * wv;
    }
    red[(kq * 16 + col) * 4 + 0] = a0;
    red[(kq * 16 + col) * 4 + 1] = a1;
    red[(kq * 16 + col) * 4 + 2] = a2;
    red[(kq * 16 + col) * 4 + 3] = a3;
    __syncthreads();
    if (tid < 64) {
      int b = tid >> 4, c2 = tid & 15;
      float sm = 0;
      for (int q = 0; q < 16; ++q) sm += red[(q * 16 + c2) * 4 + b];
      mod[(l * 4 + b) * 6144 + e0 + c2] = sm + p.mod_b[l * 6144 + e0 + c2];
    }
    __syncthreads();
  }
  if (bid == 0) {
    float* lb = (float*)(p.ws + OFF_LB);
    for (int ch = tid; ch < 1024; ch += 256) {
      float l0 = p.lb_logits[ch], l1 = p.lb_logits[1024 + ch], l2 = p.lb_logits[2048 + ch];
      float m = fmaxf(l0, fmaxf(l1, l2));
      float e0 = __expf(l0 - m), e1 = __expf(l1 - m), e2 = __expf(l2 - m);
      lb[ch] = e1 / (e0 + e1 + e2);
    }
    int* cnt = (int*)(p.ws + OFF_CNTP);
    if (tid < 48) cnt[(tid / 24) * CNT_LAYER + (tid % 24) * CNT_STRIDE] = 0;
  }
}

template <int MODE>
__device__ __forceinline__ int rowmap(int n) {
  if (MODE == 0) return n;
  if (MODE == 3) return (n & ~63) + ((n >> 2) & 3) * 16 + ((n >> 4) & 3) * 4 + (n & 3);
  return (n >> 4) * 32 + (MODE - 1) * 16 + (n & 15);
}
template <int MODE>
__device__ __forceinline__ void conv_mat(const float* src, int lds_, int K, int N, bf16_t* dst, int ldd, int dk0, const float* scale,
                         int bid, int nb, char* smem, int& woff, int smode = 1) {
  const int t_ = tid_fresh(), lane = t_ & 63, wv = t_ >> 6;
  float* tile = (float*)(smem - ((t_ >> 8) * 65536)) + wv * (64 * 33);
  const int gw = (bid >> 1) * 8 + wv, nw = (nb >> 1) * 8;
  const int tn = N >> 5, ntile = (K >> 6) * tn;
  const int lr = lane >> 3, lc = (lane & 7) * 4;
  const int on = lane & 31, okh = lane >> 5;
  const int first = (gw + nw - (woff % nw)) % nw;
  woff += ntile;
  for (int t = first; t < ntile; t += nw) {
    const int k0 = (t / tn) * 64, n0 = (t % tn) * 32;
    float4 v[8];
#pragma unroll
    for (int i = 0; i < 8; ++i) v[i] = *(const float4*)(src + (size_t)(k0 + lr + 8 * i) * lds_ + n0 + lc);
#pragma unroll
    for (int i = 0; i < 8; ++i) {
      const int r = lr + 8 * i;
      float sc = 1.f;
      if (scale) sc = (smode == 1 ? scale[k0 + r] : 1.f - scale[k0 + r]);
      float* d = tile + r * 33 + lc;
      d[0] = v[i].x * sc;
      d[1] = v[i].y * sc;
      d[2] = v[i].z * sc;
      d[3] = v[i].w * sc;
    }
    __builtin_amdgcn_wave_barrier();
    bf16_t* drow = dst + (size_t)rowmap<MODE>(n0 + on) * ldd + dk0 + k0;
#pragma unroll
    for (int q = 0; q < 4; ++q) {
      const int kc = okh + 2 * q;
      const float* tq = tile + kc * 8 * 33 + on;
      const bf16x8 o = pack8(tq[0], tq[33], tq[66], tq[99], tq[132], tq[165], tq[198], tq[231]);
      *(bf16x8*)(drow + kc * 8) = o;
    }
    __builtin_amdgcn_wave_barrier();
  }
}
__device__ __forceinline__ void ph_conv_w0(const P& p, int bid, int nb, char* smem) {
  int woff = 0;
  conv_mat<0>(p.w_in, 6672, 1024, NPROJ, (bf16_t*)(p.ws + OFF_WINT), 1024, 0, nullptr, bid, nb, smem, woff);
  conv_mat<0>(p.w_out, 1024, 2048, 1024, (bf16_t*)(p.ws + OFF_WOUTT), 2048, 0, nullptr, bid, nb, smem, woff);
}
__device__ __forceinline__ void ph_conv_w1(const P& p, int bid, int nb, char* smem) {
  int woff = 1000;
  for (int i = 0; i < 3; ++i)
    conv_mat<0>(p.w_rkv + (size_t)i * 1048576, 1024, 1024, 1024, (bf16_t*)(p.ws + OFF_WRKVT) + (size_t)i * 1048576,
                1024, 0, nullptr, bid, nb, smem, woff);
  conv_mat<0>(p.w_o, 1024, 1024, 1024, (bf16_t*)(p.ws + OFF_WOT), 1024, 0, nullptr, bid, nb, smem, woff);
  bf16_t* l1 = (bf16_t*)(p.ws + OFF_LORA1T);
  conv_mat<3>(p.dec1, 64, 1024, 64, l1, 2048, 0, p.mu + 3 * 1024, bid, nb, smem, woff, 2);
  conv_mat<3>(p.dec1, 64, 1024, 64, l1, 2048, 1024, p.mu + 3 * 1024, bid, nb, smem, woff);
  conv_mat<3>(p.a1, 64, 1024, 64, l1 + 64 * 2048, 2048, 0, p.mu + 4 * 1024, bid, nb, smem, woff, 2);
  conv_mat<3>(p.a1, 64, 1024, 64, l1 + 64 * 2048, 2048, 1024, p.mu + 4 * 1024, bid, nb, smem, woff);
  conv_mat<3>(p.g1, 128, 1024, 128, l1 + 128 * 2048, 2048, 0, p.mu + 5 * 1024, bid, nb, smem, woff, 2);
  conv_mat<3>(p.g1, 128, 1024, 128, l1 + 128 * 2048, 2048, 1024, p.mu + 5 * 1024, bid, nb, smem, woff);
  conv_mat<3>(p.dec2, 1024, 64, 1024, (bf16_t*)(p.ws + OFF_DEC2T), 64, 0, nullptr, bid, nb, smem, woff);
  conv_mat<3>(p.a2, 1024, 64, 1024, (bf16_t*)(p.ws + OFF_A2T), 64, 0, nullptr, bid, nb, smem, woff);
  conv_mat<3>(p.g2, 1024, 128, 1024, (bf16_t*)(p.ws + OFF_G2T), 128, 0, nullptr, bid, nb, smem, woff);
}
__device__ __forceinline__ void ph_conv_moe(const P& p, int layer, int bid, int nb, char* smem) {
  int woff = 0;
  for (int e = 0; e < 16; ++e) {
    size_t so = ((size_t)layer * 16 + e) * 524288;
    bf16_t* d13 = (bf16_t*)(p.ws + OFF_W13T) + (size_t)e * 1048576;
    conv_mat<1>(p.moe_w1 + so, 512, 1024, 512, d13, 1024, 0, nullptr, bid, nb, smem, woff);
    conv_mat<2>(p.moe_w3 + so, 512, 1024, 512, d13, 1024, 0, nullptr, bid, nb, smem, woff);
    conv_mat<0>(p.moe_w2 + so, 1024, 512, 1024, (bf16_t*)(p.ws + OFF_W2T) + (size_t)e * 524288, 512, 0, nullptr, bid, nb, smem, woff);
  }
}

__device__ __forceinline__ void row_norm_mod(const float* xrow, const float* nw, const float* sh, const float* sc,
                                             int lane, float (&h)[16]) {
  const float4* xr = (const float4*)xrow;
  float4 v[4];
  float ss = 0;
#pragma unroll
  for (int i = 0; i < 4; ++i) {
    v[i] = xr[lane + 64 * i];
    ss += v[i].x * v[i].x + v[i].y * v[i].y + v[i].z * v[i].z + v[i].w * v[i].w;
  }
  ss = wave_sum(ss);
  float rstd = rsqrtf(ss * (1.f / 1024.f) + 1e-6f);
#pragma unroll
  for (int i = 0; i < 4; ++i) {
    int d0 = (lane + 64 * i) * 4;
    float4 w4 = *(const float4*)(nw + d0), s4 = *(const float4*)(sh + d0), c4 = *(const float4*)(sc + d0);
    h[i * 4 + 0] = v[i].x * rstd * w4.x * (1.f + c4.x) + s4.x;
    h[i * 4 + 1] = v[i].y * rstd * w4.y * (1.f + c4.y) + s4.y;
    h[i * 4 + 2] = v[i].z * rstd * w4.z * (1.f + c4.z) + s4.z;
    h[i * 4 + 3] = v[i].w * rstd * w4.w * (1.f + c4.w) + s4.w;
  }
}
__device__ __forceinline__ void store_hbf(bf16_t* hrow, int lane, const float (&h)[16]) {
#pragma unroll
  for (int i = 0; i < 4; ++i) {
    int d0 = (lane + 64 * i) * 4;
    *(uint2*)(hrow + d0) = pack4(h[i * 4], h[i * 4 + 1], h[i * 4 + 2], h[i * 4 + 3]);
  }
}

template <int CTRL>
__device__ __forceinline__ float dpp_mov(float x) {
  return __int_as_float(__builtin_amdgcn_update_dpp(0, __float_as_int(x), CTRL, 0xf, 0xf, true));
}
__device__ __forceinline__ float row16_sum(float x) {
  x += dpp_mov<0xB1>(x);
  x += dpp_mov<0x4E>(x);
  x += dpp_mov<0x141>(x);
  x += dpp_mov<0x140>(x);
  return x;
}

__device__ __forceinline__ void tok_fill_tables(float* tb, const float* nw, const float* sh0, const float* sc0,
                                                const float* wsrc, int wstride) {
  const int t = tid_fresh();
  __syncthreads();
  for (int i = t; i < 4096; i += 512) {
    const int b = i >> 10, d = i & 1023;
    tb[i] = nw[d] * (1.f + sc0[b * 6144 + d]);
    tb[4096 + i] = sh0[b * 6144 + d];
  }
  if (wsrc) {
    for (int i = t; i < 4096; i += 512) {
      const int d = i >> 2, q = i & 3;
      const int ln = (d >> 2) & 63, ii = d >> 8, jj = d & 3;
      const float4 w4 = *(const float4*)(wsrc + (size_t)d * wstride + q * 4);
      *(float4*)(tb + 8192 + ((q * 1024) + (ii * 4 + jj) * 64 + ln) * 4) = w4;
    }
  }
  __syncthreads();
}
__device__ __forceinline__ float xpose_reduce16(const float (&v)[16], int lane) {
  const bool s3 = (lane & 8) != 0, s2 = (lane & 4) != 0, s1 = (lane & 2) != 0, s0 = (lane & 1) != 0;
  float a[8];
#pragma unroll
  for (int j = 0; j < 8; ++j) a[j] = (s3 ? v[8 + j] : v[j]) + dpp_mov<0x140>(s3 ? v[j] : v[8 + j]);
  float b[4];
#pragma unroll
  for (int j = 0; j < 4; ++j) b[j] = (s2 ? a[4 + j] : a[j]) + dpp_mov<0x141>(s2 ? a[j] : a[4 + j]);
  float c[2];
#pragma unroll
  for (int j = 0; j < 2; ++j) c[j] = (s1 ? b[2 + j] : b[j]) + dpp_mov<0x4E>(s1 ? b[j] : b[2 + j]);
  float d = (s0 ? c[1] : c[0]) + dpp_mov<0xB1>(s0 ? c[0] : c[1]);
  d += __shfl_xor(d, 16, 64);
  d += __shfl_xor(d, 32, 64);
  return d;
}
__device__ __forceinline__ void rows2_load(const float* x0, const float* x1, int lane, float4 (&v0)[4], float4 (&v1)[4]) {
#pragma unroll
  for (int i = 0; i < 4; ++i) {
    v0[i] = ((const float4*)x0)[lane + 64 * i];
    v1[i] = ((const float4*)x1)[lane + 64 * i];
  }
}
__device__ __forceinline__ void norm2_calc(const float4 (&v0)[4], const float4 (&v1)[4], const float* tb, int b, int lane,
                                           float (&h0)[16], float (&h1)[16]) {
  float ss0 = 0.f, ss1 = 0.f;
#pragma unroll
  for (int i = 0; i < 4; ++i) {
    ss0 += v0[i].x * v0[i].x + v0[i].y * v0[i].y + v0[i].z * v0[i].z + v0[i].w * v0[i].w;
    ss1 += v1[i].x * v1[i].x + v1[i].y * v1[i].y + v1[i].z * v1[i].z + v1[i].w * v1[i].w;
  }
#pragma unroll
  for (int m = 32; m >= 1; m >>= 1) {
    ss0 += __shfl_xor(ss0, m, 64);
    ss1 += __shfl_xor(ss1, m, 64);
  }
  const float r0 = rsqrtf(ss0 * (1.f / 1024.f) + 1e-6f), r1 = rsqrtf(ss1 * (1.f / 1024.f) + 1e-6f);
#pragma unroll
  for (int i = 0; i < 4; ++i) {
    const float4 sc = *(const float4*)(tb + b * 1024 + (lane + 64 * i) * 4);
    const float4 sh = *(const float4*)(tb + 4096 + b * 1024 + (lane + 64 * i) * 4);
    h0[i * 4 + 0] = v0[i].x * r0 * sc.x + sh.x;
    h0[i * 4 + 1] = v0[i].y * r0 * sc.y + sh.y;
    h0[i * 4 + 2] = v0[i].z * r0 * sc.z + sh.z;
    h0[i * 4 + 3] = v0[i].w * r0 * sc.w + sh.w;
    h1[i * 4 + 0] = v1[i].x * r1 * sc.x + sh.x;
    h1[i * 4 + 1] = v1[i].y * r1 * sc.y + sh.y;
    h1[i * 4 + 2] = v1[i].z * r1 * sc.z + sh.z;
    h1[i * 4 + 3] = v1[i].w * r1 * sc.w + sh.w;
  }
}
__device__ __forceinline__ void norm2(const float* x0, const float* x1, const float* tb, int b, int lane, float (&h0)[16],
                                      float (&h1)[16]) {
  float4 v0[4], v1[4];
  rows2_load(x0, x1, lane, v0, v1);
  norm2_calc(v0, v1, tb, b, lane, h0, h1);
}
__device__ __forceinline__ void dots2(const float* tb, int lane, const float (&h0)[16], const float (&h1)[16],
                                      float (&a0)[16], float (&a1)[16]) {
#pragma unroll
  for (int j = 0; j < 16; ++j) a0[j] = a1[j] = 0.f;
#pragma unroll
  for (int ij = 0; ij < 16; ++ij) {
#pragma unroll
    for (int q = 0; q < 4; ++q) {
      const float4 w4 = *(const float4*)(tb + 8192 + (q * 1024 + ij * 64 + lane) * 4);
      a0[q * 4 + 0] += h0[ij] * w4.x;
      a0[q * 4 + 1] += h0[ij] * w4.y;
      a0[q * 4 + 2] += h0[ij] * w4.z;
      a0[q * 4 + 3] += h0[ij] * w4.w;
      a1[q * 4 + 0] += h1[ij] * w4.x;
      a1[q * 4 + 1] += h1[ij] * w4.y;
      a1[q * 4 + 2] += h1[ij] * w4.z;
      a1[q * 4 + 3] += h1[ij] * w4.w;
    }
    if ((ij & 1) == 1) asm volatile("" ::: "memory");
  }
}

__device__ __forceinline__ void ph_norm0(const P& p, int bid, int nb, char* smem) {
  float* tb = (float*)(smem - ((tid_fresh() >> 8) * 65536));
  const float* mod = (const float*)(p.ws + OFF_MOD);
  tok_fill_tables(tb, p.norm_w, mod, mod + 1024, p.w_in + NPROJ, 6672);
  const int tf = tid_fresh(), lane = tf & 63, gw = (bid >> 1) * 8 + (tf >> 6), nw = (nb >> 1) * 8;
  bf16_t* hbf = (bf16_t*)(p.ws + OFF_S1);
  float* dt = (float*)(p.ws + OFF_DT);
  for (int ch = gw; ch < T / 8; ch += nw) {
    const int t0 = ch * 8, b = t0 >> 12;
    float4 va0[4], va1[4];
    rows2_load(p.x + (size_t)t0 * 1024, p.x + (size_t)(t0 + 1) * 1024, lane, va0, va1);
#pragma unroll 1
    for (int tt = 0; tt < 8; tt += 2) {
      const int t = t0 + tt;
      float4 vb0[4], vb1[4];
      const int tn = (tt + 2 < 8) ? t + 2 : t;
      rows2_load(p.x + (size_t)tn * 1024, p.x + (size_t)(tn + 1) * 1024, lane, vb0, vb1);
      float h0[16], h1[16], a0[16], a1[16];
      norm2_calc(va0, va1, tb, b, lane, h0, h1);
#pragma unroll
      for (int i = 0; i < 4; ++i) {
        va0[i] = vb0[i];
        va1[i] = vb1[i];
      }
      store_hbf(hbf + (size_t)t * 1024, lane, h0);
      store_hbf(hbf + (size_t)(t + 1) * 1024, lane, h1);
      dots2(tb, lane, h0, h1, a0, a1);
      const float d0 = xpose_reduce16(a0, lane), d1 = xpose_reduce16(a1, lane);
      if (lane < 16) {
        const float bias = p.dt_bias[lane];
        dt[(size_t)t * 16 + lane] = softplusf_(d0 + bias);
        dt[(size_t)(t + 1) * 16 + lane] = softplusf_(d1 + bias);
      }
    }
  }
}

__device__ __forceinline__ void ph_gemm_inproj(const P& p, int bid, int nb, char* smem) {
  const bf16_t* A = (const bf16_t*)(p.ws + OFF_S1);
  const bf16_t* B = (const bf16_t*)(p.ws + OFF_WINT);
  bf16_t* C = (bf16_t*)(p.ws + OFF_PROJ);
  const int MT = 128, NT = 52;
  for (int w = bid; w < MT * NT; w += nb) {
    int mt = w % MT, nt = w / MT;
    const bf16_t* Ab = A + (size_t)mt * 128 * 1024;
    const bf16_t* Bb = B + (size_t)nt * 128 * 1024;
    bf16_t* Cb = C + (size_t)mt * 128 * NPROJ + nt * 128;
    gemm_tile([&](int i, int r, int k) { return *(const bf16x8*)(Ab + (size_t)r * 1024 + k); },
              [&](int i, int r, int k) { return *(const bf16x8*)(Bb + (size_t)r * 1024 + k); }, 16,
              [&](f32x4(&acc)[4][4], int r0, int c0) {
#pragma unroll
                for (int m = 0; m < 4; ++m) store16(Cb + (size_t)(r0 + m * 16) * NPROJ + c0, acc[m]);
              },
              smem);
  }
}

template <bool FIRST>
__device__ __forceinline__ void ph_gemm_resid(const P& p, const bf16_t* A, int lda, const bf16_t* B, int K, const float* gate,
                              int bid, int nb, char* smem) {
  for (int w = bid; w < 128 * 8; w += nb) {
    int mt = w % 128, nt = w / 128;
    const bf16_t* Ab = A + (size_t)mt * 128 * lda;
    const bf16_t* Bb = B + (size_t)nt * 128 * K;
    const float* gt = gate + (size_t)(mt >> 5) * 6144 + nt * 128;
    gemm_tile([&](int i, int r, int k) { return *(const bf16x8*)(Ab + (size_t)r * lda + (FIRST ? (k < 1024 ? k : k + 3072) : k)); },
              [&](int i, int r, int k) { return *(const bf16x8*)(Bb + (size_t)r * K + k); }, K / 64,
              [&](f32x4(&acc)[4][4], int r0, int c0) {
#pragma unroll
                for (int m = 0; m < 4; ++m)
#pragma unroll
                  for (int n = 0; n < 4; ++n) {
                    size_t idx = (size_t)(mt * 128 + r0 + m * 16) * 1024 + nt * 128 + c0 + n * 4;
                    float4 base = FIRST ? *(const float4*)(p.x + idx) : *(const float4*)(p.out + idx);
                    float4 g4 = *(const float4*)(gt + c0 + n * 4);
                    base.x += g4.x * acc[m][n][0];
                    base.y += g4.y * acc[m][n][1];
                    base.z += g4.z * acc[m][n][2];
                    base.w += g4.w * acc[m][n][3];
                    *(float4*)(p.out + idx) = base;
                  }
              },
              smem);
  }
}

__device__ __forceinline__ void ph_conv(const P& p, int bid, int nb) {
  const bf16_t* proj = (const bf16_t*)(p.ws + OFF_PROJ);
  bf16_t* xc = (bf16_t*)p.out;
  for (int idx = bid * 256 + TIDX; idx < T * 192; idx += nb * 256) {
    int t = idx / 192, c0 = (idx % 192) * 8, tl = t & (SEQ - 1);
    float acc[8];
#pragma unroll
    for (int j = 0; j < 8; ++j) acc[j] = p.conv_b[c0 + j];
#pragma unroll
    for (int jj = 0; jj < 4; ++jj) {
      if (tl - 3 + jj >= 0) {
        bf16x8 v = *(const bf16x8*)(proj + (size_t)(t - 3 + jj) * NPROJ + 5120 + c0);
#pragma unroll
        for (int j = 0; j < 8; ++j) acc[j] += p.conv_w[jj * 1536 + c0 + j] * bfs2f(v[j]);
      }
    }
    bf16x8 o;
#pragma unroll
    for (int j = 0; j < 8; ++j) o[j] = (short)f2bf(siluf_(acc[j]));
    *(bf16x8*)(xc + (size_t)t * 1536 + c0) = o;
  }
}

constexpr int LD128 = 136;
constexpr int LD64 = 72;
constexpr size_t OFF_HS = OFF_S2;
constexpr size_t OFF_HB = 4 * MiB;
constexpr size_t OFF_SD = 5 * MiB;
__device__ __forceinline__ bf16_t* ssd_state_ptr(const P& p, int item) {
  return (bf16_t*)(item < 384 ? p.ws + 12 * MiB + (size_t)item * 131072
                              : (char*)p.out + 48 * MiB + (size_t)(item - 384) * 131072);
}
__device__ __forceinline__ f32x4 mfma16(bf16x8 a, bf16x8 b, f32x4 c) {
  return __builtin_amdgcn_mfma_f32_16x16x32_bf16(a, b, c, 0, 0, 0);
}
__device__ __forceinline__ uint32_t pack2(float a, float b) { return cvt_pk_bf16(a, b); }

__device__ __forceinline__ void load_col32(const bf16_t* col, uint32_t (&pk)[16]) {
#pragma unroll
  for (int i = 0; i < 16; ++i)
    pk[i] = (uint32_t)col[(size_t)(2 * i) * NPROJ] | ((uint32_t)col[(size_t)(2 * i + 1) * NPROJ] << 16);
}
__device__ __forceinline__ void hg_front(const uint32_t (&pf)[16], float lbk, int k, int half,
                                         float* tot, float (&fv)[32], float (&bv)[32]) {
  float run = 0.f;
#pragma unroll
  for (int i = 0; i < 32; ++i) {
    const float fr = __uint_as_float((i & 1) ? (pf[i >> 1] & 0xffff0000u) : (pf[i >> 1] << 16));
    float f = lbk + (1.f - lbk) * sigmoidf_(fr);
    fv[i] = f;
    run += __logf(f);
    bv[i] = run;
  }
  if (half == 0) tot[k] = run;
  __syncthreads();
  if (half == 1) {
    float t0 = tot[k];
#pragma unroll
    for (int i = 0; i < 32; ++i) bv[i] += t0;
  }
}

__device__ __forceinline__ void load_col32_raw(const bf16_t* col, uint32_t (&lo)[16], uint32_t (&hi)[16]) {
#pragma unroll
  for (int i = 0; i < 16; ++i) {
    lo[i] = (uint32_t)col[(size_t)(2 * i) * NPROJ];
    hi[i] = (uint32_t)col[(size_t)(2 * i + 1) * NPROJ];
  }
}
__device__ __forceinline__ void hg_phaseA(const P& p, int item, char* smem, uint32_t (&pf)[16], uint32_t (&pv)[16], int nitem) {
  const int tid = TIDX, lane = tid & 63, w = tid >> 6, fr = lane & 15, fq = lane >> 4;
  const int b = item >> 9, h = (item >> 6) & 7, c = item & 63;
  const int k = tid & 127, half = tid >> 7;
  const bf16_t* proj = (const bf16_t*)(p.ws + OFF_PROJ);
  const float* lb = (const float*)(p.ws + OFF_LB);
  bf16_t* KT = (bf16_t*)smem;
  bf16_t* VT = (bf16_t*)(smem + 18432);
  float* tot = (float*)(smem + 36864);
  float* blast = tot + 128;
  const size_t trow = (size_t)b * SEQ + c * 64 + 32 * half;
  __syncthreads();
  uint32_t nfl[16], nfh[16], nvl[16], nvh[16];
  {
    const int ni = nitem >= 0 ? nitem : item;
    const size_t ntrow = (size_t)(ni >> 9) * SEQ + (ni & 63) * 64 + 32 * half;
    const int nh = (ni >> 6) & 7;
    load_col32_raw(proj + ntrow * NPROJ + 1024 + nh * 128 + k, nfl, nfh);
    load_col32_raw(proj + ntrow * NPROJ + 2048 + nh * 128 + k, nvl, nvh);
  }
  float fv[32], bv[32];
  hg_front(pf, lb[h * 128 + k], k, half, tot, fv, bv);
  if (half == 1) blast[k] = bv[31];
  __syncthreads();
  {
    const float bl = blast[k];
    uint32_t pk[16];
#pragma unroll
    for (int i = 0; i < 16; ++i) {
      float k0 = (1.f - fv[2 * i]) * __expf(bl - bv[2 * i]);
      float k1 = (1.f - fv[2 * i + 1]) * __expf(bl - bv[2 * i + 1]);
      pk[i] = pack2(k0, k1);
    }
    uint4* kd = (uint4*)(KT + k * LD64 + 32 * half);
    uint4* vd = (uint4*)(VT + k * LD64 + 32 * half);
#pragma unroll
    for (int i = 0; i < 4; ++i) {
      kd[i] = make_uint4(pk[4 * i], pk[4 * i + 1], pk[4 * i + 2], pk[4 * i + 3]);
      vd[i] = make_uint4(pv[4 * i], pv[4 * i + 1], pv[4 * i + 2], pv[4 * i + 3]);
    }
    if (half == 1) ((float*)(p.ws + OFF_HB))[(size_t)item * 128 + k] = bl;
  }
  __syncthreads();
  f32x4 acc[2][8];
#pragma unroll
  for (int a = 0; a < 2; ++a)
#pragma unroll
    for (int vt = 0; vt < 8; ++vt) acc[a][vt] = (f32x4){0.f, 0.f, 0.f, 0.f};
#pragma unroll
  for (int ks = 0; ks < 2; ++ks) {
    bf16x8 kf[2];
#pragma unroll
    for (int a = 0; a < 2; ++a) kf[a] = *(const bf16x8*)(KT + ((2 * w + a) * 16 + fr) * LD64 + ks * 32 + fq * 8);
#pragma unroll
    for (int vt = 0; vt < 8; ++vt) {
      bf16x8 vf = *(const bf16x8*)(VT + (vt * 16 + fr) * LD64 + ks * 32 + fq * 8);
#pragma unroll
      for (int a = 0; a < 2; ++a) acc[a][vt] = mfma16(kf[a], vf, acc[a][vt]);
    }
  }
  bf16_t* hs = (bf16_t*)(p.ws + OFF_HS) + (size_t)item * 16384;
#pragma unroll
  for (int a = 0; a < 2; ++a)
#pragma unroll
    for (int vt = 0; vt < 8; ++vt)
      *(uint2*)(hs + (vt * 16 + fr) * 128 + (2 * w + a) * 16 + fq * 4) =
          pack4(acc[a][vt][0], acc[a][vt][1], acc[a][vt][2], acc[a][vt][3]);
  __builtin_amdgcn_sched_barrier(0);
#pragma unroll
  for (int i = 0; i < 16; ++i) {
    pf[i] = nfl[i] | (nfh[i] << 16);
    pv[i] = nvl[i] | (nvh[i] << 16);
  }
}

__device__ __forceinline__ void hg_phaseB(const P& p, int item, char* smem, int dry) {
  const int tid = TIDX, lane = tid & 63, w = tid >> 6, fr = lane & 15, fq = lane >> 4;
  const int b = item >> 9, h = (item >> 6) & 7, c = item & 63;
  const int k = tid & 127, half = tid >> 7;
  bf16_t* proj = (bf16_t*)(p.ws + OFF_PROJ);
  const float* lb = (const float*)(p.ws + OFF_LB);
  bf16_t* QA = (bf16_t*)smem;
  bf16_t* KM = (bf16_t*)(smem + 17408);
  bf16_t* QM = (bf16_t*)(smem + 34816);
  bf16_t* KA = (bf16_t*)(smem + 43520);
  float* tot = (float*)(smem + 52224);
  float* red = tot + 256;
  bf16_t* VT = (bf16_t*)smem;
  bf16_t* SC = (bf16_t*)(smem + 18432);
  const size_t trow0 = (size_t)b * SEQ + c * 64;
  const size_t trow = trow0 + 32 * half;
  __syncthreads();
  uint32_t pf[16], pq[16], pv[16];
  load_col32(proj + trow * NPROJ + 1024 + h * 128 + k, pf);
  load_col32(proj + trow * NPROJ + h * 128 + k, pq);
  load_col32(proj + trow * NPROJ + 2048 + h * 128 + k, pv);
  const bf16_t* hs = (const bf16_t*)(p.ws + OFF_HS) + (size_t)item * 16384;
  bf16x8 sfr[4][2];
#pragma unroll
  for (int ks = 0; ks < 4; ++ks)
#pragma unroll
    for (int a = 0; a < 2; ++a) sfr[ks][a] = *(const bf16x8*)(hs + ((2 * w + a) * 16 + fr) * 128 + ks * 32 + fq * 8);
  float fv[32], bv[32];
  hg_front(pf, lb[h * 128 + k], k, half, tot, fv, bv);
  {
    const float bmid = tot[k];
#pragma unroll
    for (int i = 0; i < 32; ++i) {
      const float q = __uint_as_float((i & 1) ? (pq[i >> 1] & 0xffff0000u) : (pq[i >> 1] << 16));
      const float kk = 1.f - fv[i];
      const int t = 32 * half + i;
      QA[t * LD128 + k] = f2bf(q * __expf(bv[i]));
      KM[t * LD128 + k] = f2bf(kk * __expf(bmid - bv[i]));
      if (half == 1) QM[i * LD128 + k] = f2bf(q * __expf(bv[i] - bmid));
      else KA[i * LD128 + k] = f2bf(kk * __expf(-bv[i]));
    }
  }
  __syncthreads();
  f32x4 acc[2][4];
#pragma unroll
  for (int a = 0; a < 2; ++a)
#pragma unroll
    for (int tt = 0; tt < 4; ++tt) acc[a][tt] = (f32x4){0.f, 0.f, 0.f, 0.f};
#pragma unroll
  for (int ks = 0; ks < 4; ++ks) {
#pragma unroll
    for (int tt = 0; tt < 4; ++tt) {
      bf16x8 qf = *(const bf16x8*)(QA + (tt * 16 + fr) * LD128 + ks * 32 + fq * 8);
#pragma unroll
      for (int a = 0; a < 2; ++a) acc[a][tt] = mfma16(sfr[ks][a], qf, acc[a][tt]);
    }
  }
  f32x4 sc2[2], sc1;
  sc2[0] = sc2[1] = sc1 = (f32x4){0.f, 0.f, 0.f, 0.f};
#pragma unroll
  for (int ks = 0; ks < 4; ++ks) {
    bf16x8 kf = *(const bf16x8*)(KM + (16 * w + fr) * LD128 + ks * 32 + fq * 8);
#pragma unroll
    for (int t2 = 0; t2 < 2; ++t2) {
      bf16x8 qf = *(const bf16x8*)(QM + (16 * t2 + fr) * LD128 + ks * 32 + fq * 8);
      sc2[t2] = mfma16(kf, qf, sc2[t2]);
    }
    bf16x8 kaf = *(const bf16x8*)(KA + (16 * (w & 1) + fr) * LD128 + ks * 32 + fq * 8);
    bf16x8 qaf = *(const bf16x8*)(QA + (16 * (w >> 1) + fr) * LD128 + ks * 32 + fq * 8);
    sc1 = mfma16(kaf, qaf, sc1);
  }
  __syncthreads();
  {
#pragma unroll
    for (int t2 = 0; t2 < 2; ++t2) {
      const int t = 32 + 16 * t2 + fr, s0 = 16 * w + fq * 4;
      float v0 = (s0 + 0 <= t) ? sc2[t2][0] : 0.f, v1 = (s0 + 1 <= t) ? sc2[t2][1] : 0.f,
            v2 = (s0 + 2 <= t) ? sc2[t2][2] : 0.f, v3 = (s0 + 3 <= t) ? sc2[t2][3] : 0.f;
      *(uint2*)(SC + t * LD64 + s0) = pack4(v0, v1, v2, v3);
    }
    {
      const int t = 16 * (w >> 1) + fr, s0 = 16 * (w & 1) + fq * 4;
      float v0 = (s0 + 0 <= t) ? sc1[0] : 0.f, v1 = (s0 + 1 <= t) ? sc1[1] : 0.f, v2 = (s0 + 2 <= t) ? sc1[2] : 0.f,
            v3 = (s0 + 3 <= t) ? sc1[3] : 0.f;
      *(uint2*)(SC + t * LD64 + s0) = pack4(v0, v1, v2, v3);
    }
    *(uint2*)(SC + (tid >> 3) * LD64 + 32 + (tid & 7) * 4) = make_uint2(0u, 0u);
    uint4* vd = (uint4*)(VT + k * LD64 + 32 * half);
#pragma unroll
    for (int i = 0; i < 4; ++i) vd[i] = make_uint4(pv[4 * i], pv[4 * i + 1], pv[4 * i + 2], pv[4 * i + 3]);
  }
  __syncthreads();
#pragma unroll
  for (int ks = 0; ks < 2; ++ks) {
    bf16x8 vf[2];
#pragma unroll
    for (int a = 0; a < 2; ++a) vf[a] = *(const bf16x8*)(VT + ((2 * w + a) * 16 + fr) * LD64 + ks * 32 + fq * 8);
#pragma unroll
    for (int tt = 0; tt < 4; ++tt) {
      bf16x8 sf = *(const bf16x8*)(SC + (tt * 16 + fr) * LD64 + ks * 32 + fq * 8);
#pragma unroll
      for (int a = 0; a < 2; ++a) acc[a][tt] = mfma16(vf[a], sf, acc[a][tt]);
    }
  }
#pragma unroll
  for (int tt = 0; tt < 4; ++tt) {
    float ss = 0.f;
#pragma unroll
    for (int a = 0; a < 2; ++a)
#pragma unroll
      for (int j = 0; j < 4; ++j) ss += acc[a][tt][j] * acc[a][tt][j];
    ss += __shfl_xor(ss, 16, 64);
    ss += __shfl_xor(ss, 32, 64);
    if (fq == 0) red[w * 64 + tt * 16 + fr] = ss;
  }
  __syncthreads();
#pragma unroll
  for (int tt = 0; tt < 4; ++tt) {
    const int t = tt * 16 + fr;
    const float ss = red[t] + red[64 + t] + red[128 + t] + red[192 + t];
    const float rstd = rsqrtf(ss * (1.f / 128.f) + 1e-6f);
    bf16_t* orow = proj + (trow0 + t) * NPROJ + h * 128;
#pragma unroll
    for (int a = 0; a < 2; ++a) {
      const int v0 = (2 * w + a) * 16 + fq * 4;
      const bf16x4 g4 = *(const bf16x4*)(orow + 3072 + v0);
      const float4 n4 = *(const float4*)(p.hg_norm + h * 128 + v0);
      if (!dry) *(uint2*)(orow + v0) = pack4(acc[a][tt][0] * rstd * n4.x * siluf_(bfs2f(g4[0])),
                                   acc[a][tt][1] * rstd * n4.y * siluf_(bfs2f(g4[1])),
                                   acc[a][tt][2] * rstd * n4.z * siluf_(bfs2f(g4[2])),
                                   acc[a][tt][3] * rstd * n4.w * siluf_(bfs2f(g4[3])));
    }
  }
}

__device__ __forceinline__ void ssd_acs(const P& p, size_t trow0, int g, float* acs, float* dts) {
  const int lane = TIDX & 63;
  if (TIDX < 64) {
    const float* dt = (const float*)(p.ws + OFF_DT) + (trow0 + lane) * 16 + g * 8;
#pragma unroll
    for (int j = 0; j < 8; ++j) {
      float d = dt[j];
      float v = d * (-__expf(p.a_log[g * 8 + j]));
#pragma unroll
      for (int off = 1; off < 64; off <<= 1) {
        float u = __shfl_up(v, off, 64);
        if (lane >= off) v += u;
      }
      acs[lane * 8 + j] = v;
      dts[lane * 8 + j] = d;
    }
  }
}

__device__ __forceinline__ void ssd_phaseA(const P& p, int item, char* smem) {
  const int tid = TIDX, lane = tid & 63, w = tid >> 6, fr = lane & 15, fq = lane >> 4;
  const int b = item >> 7, g = (item >> 6) & 1, c = item & 63;
  const bf16_t* xc = (const bf16_t*)p.out;
  bf16_t* BT = (bf16_t*)smem;
  bf16_t* XT = (bf16_t*)(smem + 18432);
  float* acs = (float*)(smem + 36864);
  float* dts = acs + 512;
  const size_t trow0 = (size_t)b * SEQ + c * 64;
  __syncthreads();
  if (tid < 192) {
    const int q = tid % 96, hf = tid / 96;
    const int col = q < 64 ? g * 512 + q * 8 : (q < 80 ? 1024 + g * 128 + (q - 64) * 8 : 1280 + g * 128 + (q - 80) * 8);
    const bf16_t* proj_ = (const bf16_t*)(p.ws + OFF_PROJ);
    bf16_t* xw = (bf16_t*)p.out;
    float wc[4][8], bc[8];
#pragma unroll
    for (int j = 0; j < 8; ++j) {
      bc[j] = p.conv_b[col + j];
#pragma unroll
      for (int jj = 0; jj < 4; ++jj) wc[jj][j] = p.conv_w[jj * 1536 + col + j];
    }
    const int ts = c * 64 + hf * 32;
    float x0[8], x1[8], x2[8];
#pragma unroll
    for (int j = 0; j < 8; ++j) x0[j] = x1[j] = x2[j] = 0.f;
    if (ts >= 3) {
      const bf16_t* r0 = proj_ + ((size_t)b * SEQ + ts - 3) * NPROJ + 5120 + col;
      const bf16x8 a = *(const bf16x8*)r0, bb = *(const bf16x8*)(r0 + NPROJ), cc = *(const bf16x8*)(r0 + 2 * NPROJ);
#pragma unroll
      for (int j = 0; j < 8; ++j) {
        x0[j] = bfs2f(a[j]);
        x1[j] = bfs2f(bb[j]);
        x2[j] = bfs2f(cc[j]);
      }
    }
#pragma unroll 1
    for (int i0 = 0; i0 < 32; i0 += 16) {
    bf16x8 rows[16];
#pragma unroll
    for (int i = 0; i < 16; ++i) rows[i] = *(const bf16x8*)(proj_ + ((size_t)b * SEQ + ts + i0 + i) * NPROJ + 5120 + col);
#pragma unroll
    for (int ii = 0; ii < 16; ++ii) {
      const int i = i0 + ii;
      const size_t tr = (size_t)b * SEQ + ts + i;
      const bf16x8 cur = rows[ii];
      bf16x8 o;
#pragma unroll
      for (int j = 0; j < 8; ++j) {
        const float x3 = bfs2f(cur[j]);
        const float acc = bc[j] + wc[0][j] * x0[j] + wc[1][j] * x1[j] + wc[2][j] * x2[j] + wc[3][j] * x3;
        o[j] = (short)f2bf(siluf_(acc));
        x0[j] = x1[j];
        x1[j] = x2[j];
        x2[j] = x3;
      }
      *(bf16x8*)(xw + tr * 1536 + col) = o;
    }
    }
  }
  __threadfence_block();
  __syncthreads();
  ssd_acs(p, trow0, g, acs, dts);
  {
    const int n = tid & 127, half = tid >> 7;
    const bf16_t* brow = xc + (trow0 + 32 * half) * 1536 + 1024 + g * 128 + n;
    uint32_t pb[16];
#pragma unroll
    for (int i = 0; i < 16; ++i)
      pb[i] = (uint32_t)brow[(size_t)(2 * i) * 1536] | ((uint32_t)brow[(size_t)(2 * i + 1) * 1536] << 16);
    uint4* bd = (uint4*)(BT + n * LD64 + 32 * half);
#pragma unroll
    for (int i = 0; i < 4; ++i) bd[i] = make_uint4(pb[4 * i], pb[4 * i + 1], pb[4 * i + 2], pb[4 * i + 3]);
  }
  __syncthreads();
  bf16_t* ss = ssd_state_ptr(p, item);
  if (tid < 8) ((float*)(p.ws + OFF_SD))[item * 8 + tid] = __expf(acs[63 * 8 + tid]);
  const int pp = tid & 63, sq = tid >> 6;
  uint32_t xr[16];
  {
    const bf16_t* xrow = xc + (trow0 + 16 * sq) * 1536 + (g * 8) * 64 + pp;
#pragma unroll
    for (int i = 0; i < 16; ++i) xr[i] = (uint32_t)xrow[(size_t)i * 1536];
  }
#pragma unroll 1
  for (int j = 0; j < 8; ++j) {
    bf16_t* xt = XT + (j & 1) * 64 * LD64;
    {
      const float al = acs[63 * 8 + j];
      uint32_t px[8];
#pragma unroll
      for (int i = 0; i < 8; ++i) {
        const int s0 = 16 * sq + 2 * i;
        float x0 = __uint_as_float(xr[2 * i] << 16) * dts[s0 * 8 + j] * __expf(al - acs[s0 * 8 + j]);
        float x1 = __uint_as_float(xr[2 * i + 1] << 16) * dts[(s0 + 1) * 8 + j] * __expf(al - acs[(s0 + 1) * 8 + j]);
        px[i] = pack2(x0, x1);
      }
      uint4* xd = (uint4*)(xt + pp * LD64 + 16 * sq);
      xd[0] = make_uint4(px[0], px[1], px[2], px[3]);
      xd[1] = make_uint4(px[4], px[5], px[6], px[7]);
    }
    {
      const int jn = j < 7 ? j + 1 : j;
      const bf16_t* xrow = xc + (trow0 + 16 * sq) * 1536 + (g * 8 + jn) * 64 + pp;
#pragma unroll
      for (int i = 0; i < 16; ++i) xr[i] = (uint32_t)xrow[(size_t)i * 1536];
    }
    __syncthreads();
    f32x4 acc[2][4];
#pragma unroll
    for (int a = 0; a < 2; ++a)
#pragma unroll
      for (int pt = 0; pt < 4; ++pt) acc[a][pt] = (f32x4){0.f, 0.f, 0.f, 0.f};
#pragma unroll
    for (int ks = 0; ks < 2; ++ks) {
      bf16x8 bfr[2];
#pragma unroll
      for (int a = 0; a < 2; ++a) bfr[a] = *(const bf16x8*)(BT + ((2 * w + a) * 16 + fr) * LD64 + ks * 32 + fq * 8);
#pragma unroll
      for (int pt = 0; pt < 4; ++pt) {
        bf16x8 xf = *(const bf16x8*)(xt + (pt * 16 + fr) * LD64 + ks * 32 + fq * 8);
#pragma unroll
        for (int a = 0; a < 2; ++a) acc[a][pt] = mfma16(bfr[a], xf, acc[a][pt]);
      }
    }
#pragma unroll
    for (int a = 0; a < 2; ++a)
#pragma unroll
      for (int pt = 0; pt < 4; ++pt)
        *(uint2*)(ss + (size_t)j * 8192 + (pt * 16 + fr) * 128 + (2 * w + a) * 16 + fq * 4) =
            pack4(acc[a][pt][0], acc[a][pt][1], acc[a][pt][2], acc[a][pt][3]);
  }
}

__device__ __forceinline__ void ssd_phaseB(const P& p, int item, char* smem, int dry) {
  const int tid = TIDX, lane = tid & 63, w = tid >> 6, fr = lane & 15, fq = lane >> 4;
  const int b = item >> 7, g = (item >> 6) & 1, c = item & 63;
  const bf16_t* xc = (const bf16_t*)p.out;
  bf16_t* proj = (bf16_t*)(p.ws + OFF_PROJ);
  bf16_t* Cs = (bf16_t*)smem;
  bf16_t* Bs = (bf16_t*)(smem + 17408);
  bf16_t* XT = (bf16_t*)(smem + 17408);
  bf16_t* SCw = (bf16_t*)(smem + 35840) + w * 16 * LD64;
  float* acs = (float*)(smem + 45056);
  float* dts = acs + 512;
  const size_t trow0 = (size_t)b * SEQ + c * 64;
  __syncthreads();
  const bf16_t* ss = ssd_state_ptr(p, item);
  const int l = 16 * w + fr;
  const int pp = tid & 63, sq = tid >> 6;
  uint32_t rl0[8], rh0[8];
  {
    const bf16_t* xrow = xc + (trow0 + 16 * sq) * 1536 + (g * 8) * 64 + pp;
#pragma unroll
    for (int i = 0; i < 8; ++i) {
      rl0[i] = (uint32_t)xrow[(size_t)(2 * i) * 1536];
      rh0[i] = (uint32_t)xrow[(size_t)(2 * i + 1) * 1536];
    }
  }
  bf16x8 sfr[4][4];
#pragma unroll
  for (int ks = 0; ks < 4; ++ks)
#pragma unroll
    for (int pt = 0; pt < 4; ++pt) sfr[ks][pt] = *(const bf16x8*)(ss + (pt * 16 + fr) * 128 + ks * 32 + fq * 8);
  ssd_acs(p, trow0, g, acs, dts);
#pragma unroll
  for (int i = 0; i < 4; ++i) {
    const int idx = tid + i * 256, row = idx >> 4, ch = idx & 15;
    const bf16_t* src = xc + (trow0 + row) * 1536 + g * 128 + ch * 8;
    *(bf16x8*)(Bs + row * LD128 + ch * 8) = *(const bf16x8*)(src + 1024);
    *(bf16x8*)(Cs + row * LD128 + ch * 8) = *(const bf16x8*)(src + 1280);
  }
  __syncthreads();
  bf16x8 cf[4];
  f32x4 cb[4];
#pragma unroll
  for (int st = 0; st < 4; ++st) cb[st] = (f32x4){0.f, 0.f, 0.f, 0.f};
#pragma unroll
  for (int ks = 0; ks < 4; ++ks) {
    cf[ks] = *(const bf16x8*)(Cs + (16 * w + fr) * LD128 + ks * 32 + fq * 8);
#pragma unroll
    for (int st = 0; st < 4; ++st) {
      bf16x8 bfr = *(const bf16x8*)(Bs + (st * 16 + fr) * LD128 + ks * 32 + fq * 8);
      cb[st] = mfma16(bfr, cf[ks], cb[st]);
    }
  }
  __syncthreads();
  float ssq = 0.f;
  uint32_t px[8];
#pragma unroll
  for (int i = 0; i < 8; ++i) px[i] = rl0[i] | (rh0[i] << 16);
#pragma unroll 1
  for (int j = 0; j < 8; ++j) {
    bf16_t* xt = XT + (j & 1) * 64 * LD64;
    {
      uint4* xd = (uint4*)(xt + pp * LD64 + 16 * sq);
      xd[0] = make_uint4(px[0], px[1], px[2], px[3]);
      xd[1] = make_uint4(px[4], px[5], px[6], px[7]);
    }
    const int jn = j < 7 ? j + 1 : j;
    uint32_t rl[8], rh[8];
    {
      const bf16_t* xrow = xc + (trow0 + 16 * sq) * 1536 + (g * 8 + jn) * 64 + pp;
#pragma unroll
      for (int i = 0; i < 8; ++i) {
        rl[i] = (uint32_t)xrow[(size_t)(2 * i) * 1536];
        rh[i] = (uint32_t)xrow[(size_t)(2 * i + 1) * 1536];
      }
    }
    bf16x4 x4[4], z4[4];
#pragma unroll
    for (int pt = 0; pt < 4; ++pt) {
      const int ch = (g * 8 + j) * 64 + pt * 16 + fq * 4;
      x4[pt] = *(const bf16x4*)(xc + (trow0 + l) * 1536 + ch);
      z4[pt] = *(const bf16x4*)(proj + (trow0 + l) * NPROJ + 4096 + ch);
    }
    const float al = acs[l * 8 + j];
#pragma unroll
    for (int st = 0; st < 4; ++st) {
      float v[4];
#pragma unroll
      for (int jj = 0; jj < 4; ++jj) {
        const int s = st * 16 + fq * 4 + jj;
        const float e = (s <= l) ? __expf(al - acs[s * 8 + j]) * dts[s * 8 + j] : 0.f;
        v[jj] = cb[st][jj] * e;
      }
      *(uint2*)(SCw + fr * LD64 + st * 16 + fq * 4) = pack4(v[0], v[1], v[2], v[3]);
    }
    __syncthreads();
    f32x4 yd[4], yo[4];
#pragma unroll
    for (int pt = 0; pt < 4; ++pt) yd[pt] = yo[pt] = (f32x4){0.f, 0.f, 0.f, 0.f};
#pragma unroll
    for (int ks = 0; ks < 2; ++ks) {
      bf16x8 sf = *(const bf16x8*)(SCw + fr * LD64 + ks * 32 + fq * 8);
#pragma unroll
      for (int pt = 0; pt < 4; ++pt) {
        bf16x8 xf = *(const bf16x8*)(xt + (pt * 16 + fr) * LD64 + ks * 32 + fq * 8);
        yd[pt] = mfma16(xf, sf, yd[pt]);
      }
    }
#pragma unroll
    for (int ks = 0; ks < 4; ++ks) {
#pragma unroll
      for (int pt = 0; pt < 4; ++pt) yo[pt] = mfma16(sfr[ks][pt], cf[ks], yo[pt]);
    }
    __builtin_amdgcn_sched_barrier(0);
#pragma unroll
    for (int ks = 0; ks < 4; ++ks)
#pragma unroll
      for (int pt = 0; pt < 4; ++pt)
        sfr[ks][pt] = *(const bf16x8*)(ss + (size_t)jn * 8192 + (pt * 16 + fr) * 128 + ks * 32 + fq * 8);
    const float el = __expf(al);
    const float dsk = p.d_skip[g * 8 + j];
#pragma unroll
    for (int pt = 0; pt < 4; ++pt) {
      const int ch = (g * 8 + j) * 64 + pt * 16 + fq * 4;
      bf16_t* zp = proj + (trow0 + l) * NPROJ + 4096 + ch;
      float y[4];
#pragma unroll
      for (int jj = 0; jj < 4; ++jj) {
        y[jj] = (yd[pt][jj] + yo[pt][jj] * el + dsk * bfs2f(x4[pt][jj])) * siluf_(bfs2f(z4[pt][jj]));
        ssq += y[jj] * y[jj];
      }
      if (!dry) *(uint2*)zp = pack4(y[0], y[1], y[2], y[3]);
    }
    __builtin_amdgcn_sched_barrier(0);
#pragma unroll
    for (int i = 0; i < 8; ++i) px[i] = rl[i] | (rh[i] << 16);
  }
  ssq += __shfl_xor(ssq, 16, 64);
  ssq += __shfl_xor(ssq, 32, 64);
  const float rstd = rsqrtf(ssq * (1.f / 512.f) + 1e-6f);
#pragma unroll 1
  for (int j = 0; j < 8; ++j) {
#pragma unroll
    for (int pt = 0; pt < 4; ++pt) {
      const int ch = (g * 8 + j) * 64 + pt * 16 + fq * 4;
      bf16_t* zp = proj + (trow0 + l) * NPROJ + 4096 + ch;
      const bf16x4 y4 = *(const bf16x4*)zp;
      const float4 n4 = *(const float4*)(p.ssm_norm + ch);
      if (!dry) *(uint2*)zp = pack4(bfs2f(y4[0]) * rstd * n4.x, bfs2f(y4[1]) * rstd * n4.y, bfs2f(y4[2]) * rstd * n4.z,
                          bfs2f(y4[3]) * rstd * n4.w);
    }
  }
}

__device__ __forceinline__ void ph_mixA(const P& p, int bid, int nb, char* smem) {
  int it = bid;
  for (; it < 512; it += nb) ssd_phaseA(p, it, smem);
  if (it < 2560) {
    uint32_t pf[16], pv[16];
    {
      const int item = it - 512, k = TIDX & 127, half = TIDX >> 7;
      const bf16_t* proj = (const bf16_t*)(p.ws + OFF_PROJ);
      const size_t trow = (size_t)(item >> 9) * SEQ + (item & 63) * 64 + 32 * half;
      const int h = (item >> 6) & 7;
      load_col32(proj + trow * NPROJ + 1024 + h * 128 + k, pf);
      load_col32(proj + trow * NPROJ + 2048 + h * 128 + k, pv);
    }
    for (; it < 2560; it += nb) hg_phaseA(p, it - 512, smem, pf, pv, it + nb < 2560 ? it + nb - 512 : -1);
  }
}
__device__ __forceinline__ void ph_mixB(const P& p, int bid, int nb, char* smem, int dry) {
  for (int it = bid; it < 2560; it += nb) {
    if (it < 512) ssd_phaseB(p, it, smem, dry);
    else hg_phaseB(p, it - 512, smem, dry);
  }
}
__device__ __forceinline__ void ph_mixS(const P& p, int bid, int nb) {
  for (int gid = bid * 256 + TIDX; gid < 262144; gid += nb * 256) {
    if (gid < 131072) {
      const int bh = gid >> 12, v = (gid >> 5) & 127, kq = gid & 31;
      bf16_t* base = (bf16_t*)(p.ws + OFF_HS) + (size_t)bh * 64 * 16384 + v * 128 + kq * 4;
      const float* hb = (const float*)(p.ws + OFF_HB) + (size_t)bh * 64 * 128 + kq * 4;
      float s0 = 0.f, s1 = 0.f, s2 = 0.f, s3 = 0.f;
#pragma unroll 1
      for (int c0 = 0; c0 < 64; c0 += 8) {
        uint2 d[8];
        float4 bl[8];
#pragma unroll
        for (int j = 0; j < 8; ++j) {
          d[j] = *(const uint2*)(base + (size_t)(c0 + j) * 16384);
          bl[j] = *(const float4*)(hb + (c0 + j) * 128);
        }
#pragma unroll
        for (int j = 0; j < 8; ++j) {
          *(uint2*)(base + (size_t)(c0 + j) * 16384) = pack4(s0, s1, s2, s3);
          s0 = __expf(bl[j].x) * s0 + __uint_as_float(d[j].x << 16);
          s1 = __expf(bl[j].y) * s1 + __uint_as_float(d[j].x & 0xffff0000u);
          s2 = __expf(bl[j].z) * s2 + __uint_as_float(d[j].y << 16);
          s3 = __expf(bl[j].w) * s3 + __uint_as_float(d[j].y & 0xffff0000u);
        }
      }
    } else {
      const int g2 = gid - 131072;
      const int bhd = g2 >> 11, pp = (g2 >> 5) & 63, nq = g2 & 31;
      const int b = bhd >> 4, hd = bhd & 15, g = hd >> 3, j8 = hd & 7;
      const float* sd = (const float*)(p.ws + OFF_SD);
      float s0 = 0.f, s1 = 0.f, s2 = 0.f, s3 = 0.f;
#pragma unroll 1
      for (int c0 = 0; c0 < 64; c0 += 8) {
        uint2 d[8];
        float dec[8];
#pragma unroll
        for (int j = 0; j < 8; ++j) {
          const int item = (b * 2 + g) * 64 + c0 + j;
          d[j] = *(const uint2*)(ssd_state_ptr(p, item) + (size_t)j8 * 8192 + pp * 128 + nq * 4);
          dec[j] = sd[item * 8 + j8];
        }
#pragma unroll
        for (int j = 0; j < 8; ++j) {
          const int item = (b * 2 + g) * 64 + c0 + j;
          *(uint2*)(ssd_state_ptr(p, item) + (size_t)j8 * 8192 + pp * 128 + nq * 4) = pack4(s0, s1, s2, s3);
          s0 = dec[j] * s0 + __uint_as_float(d[j].x << 16);
          s1 = dec[j] * s1 + __uint_as_float(d[j].x & 0xffff0000u);
          s2 = dec[j] * s2 + __uint_as_float(d[j].y << 16);
          s3 = dec[j] * s3 + __uint_as_float(d[j].y & 0xffff0000u);
        }
      }
    }
  }
}
namespace g8 {
constexpr int BM = 256, BK = 64, HALF = 128, HTB = HALF * BK * 2, STAGE_BYTES = 8 * HTB, NXCD = 8, WGM = 8;
__device__ __forceinline__ int lds_byte(int r, int c) {
  const int st = (r >> 4) * 2 + (c >> 5), rr = r & 15, cc = c & 31, ob = rr * 64 + cc * 2;
  return st * 1024 + (ob ^ (((ob >> 9) & 1) << 5));
}
__device__ __forceinline__ void stage_rc(int b, int& R, int& C) {
  const int st = b / 1024, sb = b % 1024, swz = sb ^ (((sb >> 9) & 1) << 5);
  R = (st >> 1) * 16 + swz / 64;
  C = (st & 1) * 32 + (swz % 64) / 2;
}
__device__ __forceinline__ int perm32(int rho) {
  const int n = rho >> 4, i = rho & 15;
  return 8 * (i >> 2) + 4 * n + (i & 3);
}
struct Unit {
  int pm, pn, aux;
  const char* A;
  const char* B;
  long bjb;
  const int* lst;
  int n, slot0, sbase;
  int half;
};
struct Gemm {
  int lda, ldb, K;
  int ajt, bjt;
  long ajb;
};
__device__ __forceinline__ void tile_order(int L, int nM, int nN, int& pm, int& pn) {
  const int nwg = nM * nN;
  int wgid = L;
  {
    const int q = nwg / NXCD, r = nwg % NXCD, xcd = wgid % NXCD, off = wgid / NXCD;
    wgid = (xcd < r ? xcd * (q + 1) : r * (q + 1) + (xcd - r) * q) + off;
  }
  const int nig = WGM * nN, gid = wgid / nig, fm = gid * WGM, gsz = (nM - fm) < WGM ? (nM - fm) : WGM;
  pm = fm + ((wgid % nig) % gsz);
  pn = (wgid % nig) / gsz;
}

template <bool GATHER, class Epi, class Sched>
__device__ __forceinline__ void gemm_phase(LAS unsigned char* lds, const Gemm g, const Sched& S, const Epi& E) {
  const int tid = tid_fresh(), wid = __builtin_amdgcn_readfirstlane(tid >> 6), lane = tid & 63, wr = wid >> 2,
            wc = wid & 3, fr = lane & 15, fq = lane >> 4;
  const int nt = g.K / BK;
  Unit cur, nxt;
  unsigned voffA[2], voffB[2];
  unsigned vA[2][2][2];
#pragma unroll
  for (int i = 0; i < 2; ++i) {
    int R, C;
    stage_rc(tid * 16 + i * 8192, R, C);
    const int Rb = Epi::PERM ? ((R & ~31) + perm32(R & 31)) : R;
    voffA[i] = (unsigned)(R * g.lda + C) * 2u;
    voffB[i] = (unsigned)(Rb * g.ldb + C) * 2u;
  }
  auto gather = [&](const Unit& u, unsigned (&v)[2][2]) {
#pragma unroll
    for (int h = 0; h < 2; ++h)
#pragma unroll
      for (int i = 0; i < 2; ++i) {
        int R, C;
        stage_rc(tid_fresh() * 16 + i * 8192, R, C);
        const int slot = u.slot0 + h * HALF + R;
        const int tok = u.lst[slot < u.n ? slot : 0];
        v[h][i] = (unsigned)(tok * g.lda + C) * 2u;
      }
  };
  const long kstep = (long)(BK * 2);
  const long hstepA = (long)HALF * g.lda * 2, hstepB = (long)HALF * g.ldb * 2;
  const unsigned ldsw = (unsigned)wid * 1024u;
  const int aoff = lds_byte(wr * 64 + fr, fq * 8), boff = lds_byte(wc * 32 + fr, fq * 8);
  auto akoff = [&](int t) -> long { return (long)t * kstep + (t >= g.ajt ? g.ajb : 0l); };
  auto bkoff = [&](int t) -> long { return (long)t * kstep + (t >= g.bjt ? cur.bjb : 0l); };
#define G8_SA(b, h) (((b) * 2 + (h)) * HTB)
#define G8_SB(b, h) ((4 + (b) * 2 + (h)) * HTB)
#define G8_STAGE(bufoff, gbase, voff)                                                                              \
  do {                                                                                                             \
    _Pragma("unroll") for (int _i = 0; _i < 2; ++_i) __builtin_amdgcn_global_load_lds(                           \
        (const unsigned*)((const char*)(gbase) + (voff)[_i]), (LAS unsigned*)(lds + (bufoff) + ldsw + _i * 8192), \
        16, 0, 0);                                                                                                 \
  } while (0)
#define G8_STAGE_A(bufoff, kptr, h, isnext)                                                                        \
  do {                                                                                                             \
    if (GATHER) {                                                                                                  \
      unsigned _v[2];                                                                                              \
      _v[0] = (isnext) ? vA[1][h][0] : vA[0][h][0];                                                                \
      _v[1] = (isnext) ? vA[1][h][1] : vA[0][h][1];                                                                \
      G8_STAGE(bufoff, kptr, _v);                                                                                  \
    } else {                                                                                                       \
      G8_STAGE(bufoff, (kptr) + (h) * hstepA, voffA);                                                              \
    }                                                                                                              \
  } while (0)
#define G8_LDA(dst, b, h)                                                                                 \
  do {                                                                                                    \
    _Pragma("unroll") for (int m = 0; m < 4; ++m) _Pragma("unroll") for (int k = 0; k < 2; ++k) dst[m][k] = \
        *(const LAS bf16x8*)(lds + G8_SA(b, h) + aoff + m * 2048 + k * 1024);                             \
  } while (0)
#define G8_LDB(dst, b, h)                                                                                 \
  do {                                                                                                    \
    _Pragma("unroll") for (int n = 0; n < 2; ++n) _Pragma("unroll") for (int k = 0; k < 2; ++k) dst[n][k] = \
        *(const LAS bf16x8*)(lds + G8_SB(b, h) + boff + n * 2048 + k * 1024);                             \
  } while (0)
#define G8_MMA(ai, bj, At, Bt)                                                                                     \
  do {                                                                                                             \
    __builtin_amdgcn_s_setprio(1);                                                                                 \
    _Pragma("unroll") for (int m = 0; m < 4; ++m) _Pragma("unroll") for (int n = 0; n < 2; ++n)                  \
        _Pragma("unroll") for (int k = 0; k < 2; ++k) acc[ai][bj][m][n] =                                         \
            __builtin_amdgcn_mfma_f32_16x16x32_bf16(Bt[n][k], At[m][k], acc[ai][bj][m][n], 0, 0, 0);               \
    __builtin_amdgcn_s_setprio(0);                                                                                 \
  } while (0)
#define G8_WAIT_V(n) asm volatile("s_waitcnt vmcnt(" #n ")" ::: "memory")
#define G8_WAIT_L(n) asm volatile("s_waitcnt lgkmcnt(" #n ")" ::: "memory")
#define G8_BAR __builtin_amdgcn_s_barrier()
#define G8_SCHED __builtin_amdgcn_sched_barrier(0)
  int ui = 0;
  if (!S.next(0, cur)) return;
  f32x4 acc[2][2][4][2];
#pragma unroll
  for (int a = 0; a < 2; ++a)
#pragma unroll
    for (int b = 0; b < 2; ++b)
#pragma unroll
      for (int m = 0; m < 4; ++m)
#pragma unroll
        for (int n = 0; n < 2; ++n) acc[a][b][m][n] = (f32x4){0.f, 0.f, 0.f, 0.f};
  bf16x8 At[4][2], B0[2][2], B1[2][2];
  const char* cA = cur.A;
  const char* cB = cur.B;
  if (GATHER) gather(cur, vA[0]);
  G8_STAGE(G8_SB(0, 0), cB, voffB);
  G8_STAGE_A(G8_SA(0, 0), cA, 0, false);
  G8_STAGE(G8_SB(0, 1), cB + hstepB, voffB);
  G8_STAGE_A(G8_SA(0, 1), cA, 1, false);
  if (wr == 1) G8_BAR;
  G8_WAIT_V(4);
  G8_BAR;
  G8_STAGE(G8_SB(1, 0), cB + kstep, voffB);
  G8_STAGE_A(G8_SA(1, 0), cA + kstep, 0, false);
  G8_STAGE(G8_SB(1, 1), cB + hstepB + kstep, voffB);
  G8_WAIT_V(6);
  G8_BAR;
  for (;;) {
    const bool has_next = S.next(ui + 1, nxt);
    const bool hf = Sched::HALFSKIP && __builtin_amdgcn_readfirstlane(cur.half) != 0;
    const char* nA = has_next ? nxt.A : cA;
    const char* nB = has_next ? nxt.B : cB;
    if (GATHER) {
      if (has_next) gather(nxt, vA[1]);
      else {
#pragma unroll
        for (int h = 0; h < 2; ++h)
#pragma unroll
          for (int i = 0; i < 2; ++i) vA[1][h][i] = vA[0][h][i];
      }
    }
    for (int t = 0; t < nt; t += 2) {
      const bool last = (t == nt - 2);
      const char* a1 = cA + akoff(t + 1);
      const char* a2 = last ? nA : cA + akoff(t + 2);
      const char* b2 = last ? nB : cB + bkoff(t + 2);
      const char* a3 = last ? nA + kstep : cA + akoff(t + 3);
      const char* b3 = last ? nB + kstep : cB + bkoff(t + 3);
      G8_LDB(B0, 0, 0); G8_SCHED; G8_LDA(At, 0, 0); G8_STAGE_A(G8_SA(1, 1), a1, 1, false);
      G8_WAIT_L(8); G8_BAR; G8_WAIT_L(0); G8_MMA(0, 0, At, B0); G8_BAR; G8_SCHED;
      G8_LDB(B1, 0, 1); G8_STAGE(G8_SB(0, 0), b2, voffB);
      G8_BAR; G8_WAIT_L(0); G8_MMA(0, 1, At, B1); G8_BAR;
      if (!hf) G8_LDA(At, 0, 1);
      G8_STAGE_A(G8_SA(0, 0), a2, 0, last);
      G8_BAR; G8_WAIT_L(0); if (!hf) G8_MMA(1, 0, At, B0); G8_BAR; G8_SCHED;
      G8_STAGE(G8_SB(0, 1), b2 + hstepB, voffB);
      G8_WAIT_V(6); G8_BAR; if (!hf) G8_MMA(1, 1, At, B1); G8_BAR;
      G8_LDB(B0, 1, 0); G8_SCHED; G8_LDA(At, 1, 0); G8_STAGE_A(G8_SA(0, 1), a2, 1, last);
      G8_WAIT_L(8); G8_BAR; G8_WAIT_L(0); G8_MMA(0, 0, At, B0); G8_BAR; G8_SCHED;
      G8_LDB(B1, 1, 1); G8_STAGE(G8_SB(1, 0), b3, voffB);
      G8_BAR; G8_WAIT_L(0); G8_MMA(0, 1, At, B1); G8_BAR;
      if (!hf) G8_LDA(At, 1, 1);
      G8_STAGE_A(G8_SA(1, 0), a3, 0, last);
      G8_BAR; G8_WAIT_L(0); if (!hf) G8_MMA(1, 0, At, B0); G8_BAR; G8_SCHED;
      G8_STAGE(G8_SB(1, 1), b3 + hstepB, voffB);
      G8_WAIT_V(6); G8_BAR; if (!hf) G8_MMA(1, 1, At, B1); G8_BAR;
    }
    E(acc, cur, wr, wc, fr, fq);
    if (!has_next) break;
#pragma unroll
    for (int a = 0; a < 2; ++a)
#pragma unroll
      for (int b = 0; b < 2; ++b)
#pragma unroll
        for (int m = 0; m < 4; ++m)
#pragma unroll
          for (int n = 0; n < 2; ++n) acc[a][b][m][n] = (f32x4){0.f, 0.f, 0.f, 0.f};
    cur = nxt;
    cA = nA;
    cB = nB;
    if (GATHER) {
#pragma unroll
      for (int h = 0; h < 2; ++h)
#pragma unroll
        for (int i = 0; i < 2; ++i) vA[0][h][i] = vA[1][h][i];
    }
    ++ui;
  }
  G8_WAIT_V(0);
  if (wr == 0) G8_BAR;
  G8_BAR;
#undef G8_SA
#undef G8_SB
#undef G8_STAGE
#undef G8_STAGE_A
#undef G8_LDA
#undef G8_LDB
#undef G8_MMA
#undef G8_WAIT_V
#undef G8_WAIT_L
#undef G8_BAR
#undef G8_SCHED
}

struct EpiBf16 {
  static constexpr bool PERM = true;
  bf16_t* O;
  int ldc;
  long unit_stride;
  __device__ __forceinline__ void operator()(const f32x4 (&acc)[2][2][4][2], const Unit& u, int wr, int wc, int fr,
                                             int fq) const {
    const int row0 = u.pm * BM + u.slot0 + wr * 64 + fr, col0 = u.pn * BM + wc * 32 + 8 * fq;
    bf16_t* base = O + (long)u.aux * unit_stride;
#pragma unroll
    for (int ai = 0; ai < 2; ++ai) {
      if (ai == 1 && u.half) break;
#pragma unroll
      for (int m = 0; m < 4; ++m) {
        bf16_t* rowp = base + (long)(row0 + ai * HALF + m * 16) * ldc + col0;
#pragma unroll
        for (int bj = 0; bj < 2; ++bj) {
          const f32x4 v0 = acc[ai][bj][m][0], v1 = acc[ai][bj][m][1];
          uint4 o;
          o.x = pack2(v0[0], v0[1]);
          o.y = pack2(v0[2], v0[3]);
          o.z = pack2(v1[0], v1[1]);
          o.w = pack2(v1[2], v1[3]);
          *(uint4*)(rowp + bj * HALF) = o;
        }
      }
    }
  }
};
struct EpiResid {
  static constexpr bool PERM = false;
  const float* base;
  float* out;
  const float* gate;
  int dry;
  __device__ __forceinline__ void operator()(const f32x4 (&acc)[2][2][4][2], const Unit& u, int wr, int wc, int fr,
                                             int fq) const {
    const int row0 = u.pm * BM + wr * 64 + fr, col0 = u.pn * BM + wc * 32 + 4 * fq;
    const float* gt = gate + (long)(u.pm >> 4) * 6144 + col0;
    f32x4 gv[2][2];
#pragma unroll
    for (int bj = 0; bj < 2; ++bj)
#pragma unroll
      for (int n = 0; n < 2; ++n) gv[bj][n] = *(const f32x4*)(gt + bj * HALF + n * 16);
#pragma unroll
    for (int ai = 0; ai < 2; ++ai)
#pragma unroll
      for (int m = 0; m < 4; ++m) {
        const long ro = (long)(row0 + ai * HALF + m * 16) * 1024 + col0;
#pragma unroll
        for (int bj = 0; bj < 2; ++bj)
#pragma unroll
          for (int n = 0; n < 2; ++n) {
            const f32x4 b4 = *(const f32x4*)(base + ro + bj * HALF + n * 16);
            if (!dry) *(f32x4*)(out + ro + bj * HALF + n * 16) = b4 + gv[bj][n] * acc[ai][bj][m][n];
          }
      }
  }
};
struct StaticSched {
  static constexpr bool HALFSKIP = false;
  const char* A;
  const char* B;
  long strideA, strideB, tstepA, tstepB;
  int nM, nN, nprob, G, c;
  __device__ __forceinline__ bool next(int i, Unit& u) const {
    const int L = i * G + c, per = nM * nN;
    if (L >= per * nprob) return false;
    const int pr = L / per;
    tile_order(L - pr * per, nM, nN, u.pm, u.pn);
    u.aux = pr;
    u.A = A + (long)pr * strideA + (long)u.pm * tstepA;
    u.B = B + (long)pr * strideB + (long)u.pn * tstepB;
    u.bjb = 0;
    u.lst = nullptr;
    u.n = 0;
    u.slot0 = 0;
    u.sbase = 0;
    u.half = 0;
    return true;
  }
};
struct StaticSplitSched {
  static constexpr bool HALFSKIP = true;
  const char* A;
  const char* B;
  long tstepA, tstepB;
  int nM, nN, G, c;
  __device__ __forceinline__ bool next(int i, Unit& u) const {
    const int L = i * G + c, U = nM * nN, full = (U / G) * G, rem = U - full;
    const bool split = rem > 0 && 2 * rem <= G;
    int base = L, h = 0, hf = 0;
    if (split && L >= full) {
      const int j = L - full;
      if (j >= 2 * rem) return false;
      base = full + (j >> 1);
      h = j & 1;
      hf = 1;
    } else if (L >= U) {
      return false;
    }
    tile_order(base, nM, nN, u.pm, u.pn);
    u.aux = 0;
    u.A = A + (long)u.pm * tstepA + (long)h * (tstepA >> 1);
    u.B = B + (long)u.pn * tstepB;
    u.bjb = 0;
    u.lst = nullptr;
    u.n = 0;
    u.slot0 = h * HALF;
    u.sbase = 0;
    u.half = hf;
    return true;
  }
};
}

__device__ __forceinline__ void ph8_inproj(const P& p, LAS unsigned char* lds) {
  g8::Gemm g{1024, 1024, 1024, 1 << 20, 1 << 20, 0};
  g8::StaticSplitSched S{(const char*)(p.ws + OFF_S1), (const char*)(p.ws + OFF_WINT), 256l * 1024 * 2,
                         256l * 1024 * 2, 64, 26, (int)gridDim.x, (int)blockIdx.x};
  g8::EpiBf16 E{(bf16_t*)(p.ws + OFF_PROJ), NPROJ, 0};
  g8::gemm_phase<false>(lds, g, S, E);
}
__device__ __forceinline__ void ph8_outproj(const P& p, LAS unsigned char* lds) {
  g8::Gemm g{NPROJ, 2048, 2048, 16, 1 << 20, 3072l * 2};
  g8::StaticSched S{(const char*)(p.ws + OFF_PROJ), (const char*)(p.ws + OFF_WOUTT), 0, 0, 256l * NPROJ * 2,
                    256l * 2048 * 2, 64, 4, 1, (int)gridDim.x, (int)blockIdx.x};
  g8::EpiResid E{p.x, p.out, (const float*)(p.ws + OFF_MOD) + 2048, 0};
  g8::gemm_phase<false>(lds, g, S, E);
}
__device__ __forceinline__ void ph8_rkv(const P& p, LAS unsigned char* lds) {
  g8::Gemm g{1024, 1024, 1024, 1 << 20, 1 << 20, 0};
  g8::StaticSched S{(const char*)(p.ws + OFF_KK), (const char*)(p.ws + OFF_WRKVT), (long)(32 * MiB), 1024l * 1024 * 2,
                    256l * 1024 * 2, 256l * 1024 * 2, 64, 4, 3, (int)gridDim.x, (int)blockIdx.x};
  g8::EpiBf16 E{(bf16_t*)(p.ws + OFF_R), 1024, (long)(16 * MiB)};
  g8::gemm_phase<false>(lds, g, S, E);
}
__device__ __forceinline__ void ph8_wo(const P& p, LAS unsigned char* lds, int dry = 0) {
  g8::Gemm g{1024, 1024, 1024, 1 << 20, 1 << 20, 0};
  g8::StaticSched S{(const char*)(p.ws + OFF_S1), (const char*)(p.ws + OFF_WOT), 0, 0, 256l * 1024 * 2,
                    256l * 1024 * 2, 64, 4, 1, (int)gridDim.x, (int)blockIdx.x};
  g8::EpiResid E{p.out, p.out, (const float*)(p.ws + OFF_MOD) + 4 * 6144 + 2048, dry};
  g8::gemm_phase<false>(lds, g, S, E);
}

__device__ __forceinline__ int route_one(const P& p, int t, float logit_lane, int lane, float* gates) {
    float lg[16];
#pragma unroll
    for (int j = 0; j < 16; ++j)
      lg[j] = __int_as_float(__builtin_amdgcn_readlane(__float_as_int(logit_lane), j)) + p.router_b[j];
    float mx = -1e30f;
#pragma unroll
    for (int j = 0; j < 16; ++j) mx = fmaxf(mx, lg[j]);
    float sum = 0.f;
#pragma unroll
    for (int j = 0; j < 16; ++j) {
      lg[j] = __expf(lg[j] - mx);
      sum += lg[j];
    }
    float inv = 1.f / sum;
#pragma unroll
    for (int j = 0; j < 16; ++j) lg[j] *= inv;
    int best = 0;
    float bests = -1.f;
    float q0 = 0, q1 = 0, q2 = 0, q3 = 0;
#pragma unroll
    for (int g = 0; g < 4; ++g) {
      float a0 = lg[g * 4], a1 = lg[g * 4 + 1], a2 = lg[g * 4 + 2], a3 = lg[g * 4 + 3];
      float hi01 = fmaxf(a0, a1), lo01 = fminf(a0, a1), hi23 = fmaxf(a2, a3), lo23 = fminf(a2, a3);
      float m1 = fmaxf(hi01, hi23);
      float m2 = fmaxf(fminf(hi01, hi23), fmaxf(lo01, lo23));
      float s = m1 + m2;
      if (s > bests) {
        bests = s;
        best = g;
        q0 = a0;
        q1 = a1;
        q2 = a2;
        q3 = a3;
      }
    }
    int i1 = 0;
    float v1 = q0;
    if (q1 > v1) { v1 = q1; i1 = 1; }
    if (q2 > v1) { v1 = q2; i1 = 2; }
    if (q3 > v1) { v1 = q3; i1 = 3; }
    int i2 = -1;
    float v2 = -1.f;
    if (i1 != 0 && q0 > v2) { v2 = q0; i2 = 0; }
    if (i1 != 1 && q1 > v2) { v2 = q1; i2 = 1; }
    if (i1 != 2 && q2 > v2) { v2 = q2; i2 = 2; }
    if (i1 != 3 && q3 > v2) { v2 = q3; i2 = 3; }
    float wsum = v1 + v2;
    float g1 = v1 / wsum, g2 = v2 / wsum;
    int lo = i1 < i2 ? i1 : i2, hi = i1 < i2 ? i2 : i1;
    float glo = i1 < i2 ? g1 : g2, ghi = i1 < i2 ? g2 : g1;
    int pidx = (lo == 0) ? (hi - 1) : ((lo == 1) ? (hi + 1) : 5);
    int combo = best * 6 + pidx;
    if (lane == 0) {
      gates[(size_t)t * 2] = glo;
      gates[(size_t)t * 2 + 1] = ghi;
    }
    return combo;
}

__device__ __forceinline__ void ph_route(const P& p, int layer, int bid, int nb, char* smem) {
  float* tb = (float*)(smem - ((tid_fresh() >> 8) * 65536));
  const float* mod = (const float*)(p.ws + OFF_MOD) + (size_t)layer * 4 * 6144;
  tok_fill_tables(tb, p.norm_w + (layer * 2 + 1) * 1024, mod + 3072, mod + 4096, p.router_w, 16);
  const int tf = tid_fresh(), lane = tf & 63, gw = (bid >> 1) * 8 + (tf >> 6), nw = (nb >> 1) * 8;
  bf16_t* hbf = (bf16_t*)(p.ws + OFF_S1);
  int* cnt = (int*)(p.ws + OFF_CNTP) + layer * CNT_LAYER;
  int* list = (int*)(p.ws + OFF_LIST);
  float* gates = (float*)(p.ws + OFF_GATES);
  for (int ch = gw; ch < T / 8; ch += nw) {
    const int t0 = ch * 8, b = t0 >> 12;
    int mycombo = 0;
    float4 va0[4], va1[4];
    rows2_load(p.out + (size_t)t0 * 1024, p.out + (size_t)(t0 + 1) * 1024, lane, va0, va1);
#pragma unroll 1
    for (int tt = 0; tt < 8; tt += 2) {
      const int t = t0 + tt;
      float4 vb0[4], vb1[4];
      const int tn = (tt + 2 < 8) ? t + 2 : t;
      rows2_load(p.out + (size_t)tn * 1024, p.out + (size_t)(tn + 1) * 1024, lane, vb0, vb1);
      float h0[16], h1[16], a0[16], a1[16];
      norm2_calc(va0, va1, tb, b, lane, h0, h1);
#pragma unroll
      for (int i = 0; i < 4; ++i) {
        va0[i] = vb0[i];
        va1[i] = vb1[i];
      }
      store_hbf(hbf + (size_t)t * 1024, lane, h0);
      store_hbf(hbf + (size_t)(t + 1) * 1024, lane, h1);
      dots2(tb, lane, h0, h1, a0, a1);
      const float d0 = xpose_reduce16(a0, lane), d1 = xpose_reduce16(a1, lane);
      const int c0 = route_one(p, t, d0, lane, gates);
      const int c1 = route_one(p, t + 1, d1, lane, gates);
      mycombo = lane == tt ? c0 : (lane == tt + 1 ? c1 : mycombo);
    }
    if (lane < 8) {
      const int slot = atomicAdd(&cnt[mycombo * CNT_STRIDE], 1);
      list[(size_t)mycombo * T + slot] = t0 + lane;
    }
  }
}

struct MoeMap {
  int pre[25];
};
__device__ __forceinline__ void moe_find(const int* cnt, int tg, int& combo, int& mt, int& n, int& sbase) {
  int acc = 0;
  combo = 0;
  mt = 0;
  n = 0;
  sbase = 0;
  bool found = false;
  for (int c = 0; c < 24; ++c) {
    int cc = cnt[c];
    int nt = (cc + 127) >> 7;
    if (!found && tg < acc + nt) {
      combo = c;
      mt = tg - acc;
      n = cc;
      sbase = acc * 128;
      found = true;
    }
    acc += nt;
  }
}
__device__ __forceinline__ int moe_total_tiles(const int* cnt) {
  int acc = 0;
  for (int c = 0; c < 24; ++c) acc += (cnt[c] + 127) >> 7;
  return acc;
}
__device__ __forceinline__ void combo_experts(int combo, int& e1, int& e2) {
  int g = combo / 6, pi = combo % 6;
  int lo = pi < 3 ? 0 : (pi < 5 ? 1 : 2);
  int hi = pi < 3 ? pi + 1 : (pi < 5 ? pi - 1 : 3);
  e1 = g * 4 + lo;
  e2 = g * 4 + hi;
}

__device__ __forceinline__ void ph_moe_up(const P& p, int layer, int bid, int nb, char* smem) {
  const int* cnt = (const int*)(p.ws + OFF_CNT) + layer * 32;
  const int* list = (const int*)(p.ws + OFF_LIST);
  const float* gates = (const float*)(p.ws + OFF_GATES);
  const bf16_t* hbf = (const bf16_t*)(p.ws + OFF_S1);
  const bf16_t* W13 = (const bf16_t*)(p.ws + OFF_W13T);
  bf16_t* hid = (bf16_t*)(p.ws + OFF_HID);
  const int TT = moe_total_tiles(cnt);
  const int tid = TIDX;
  for (int w = bid; w < TT * 16; w += nb) {
    int tg = w >> 4, nt = w & 15;
    int combo, mt, n, sbase;
    moe_find(cnt, tg, combo, mt, n, sbase);
    int e1, e2;
    combo_experts(combo, e1, e2);
    const int e = nt < 8 ? e1 : e2;
    const int* lst = list + (size_t)combo * T;
    const bf16_t* Bb = W13 + (size_t)e * 1048576 + (size_t)(nt & 7) * 128 * 1024;
    const bf16_t* arow[4];
#pragma unroll
    for (int i = 0; i < 4; ++i) {
      int slot = mt * 128 + (tid >> 3) + 32 * i;
      int tok = lst[slot < n ? slot : 0];
      arow[i] = hbf + (size_t)tok * 1024;
    }
    gemm_tile([&](int i, int r, int k) { return *(const bf16x8*)(arow[i] + k); },
              [&](int i, int r, int k) { return *(const bf16x8*)(Bb + (size_t)r * 1024 + k); }, 16,
              [&](f32x4(&acc)[4][4], int r0, int c0) {
                const int wc = c0 >> 6, fq = (c0 >> 4) & 3;
                const int hc = (nt >> 3) * 512 + (nt & 7) * 64 + wc * 32 + fq * 8;
#pragma unroll
                for (int m = 0; m < 4; ++m) {
                  int slot = mt * 128 + r0 + m * 16;
                  int tok = lst[slot < n ? slot : 0];
                  float gate = gates[(size_t)tok * 2 + (nt >> 3)];
                  bf16x8 o8;
#pragma unroll
                  for (int np = 0; np < 2; ++np)
#pragma unroll
                    for (int j = 0; j < 4; ++j)
                      o8[np * 4 + j] = (short)f2bf(siluf_(acc[m][2 * np][j]) * acc[m][2 * np + 1][j] * gate);
                  *(bf16x8*)(hid + (size_t)(sbase + slot) * 1024 + hc) = o8;
                }
              },
              smem);
  }
}

__device__ __forceinline__ void ph_moe_down(const P& p, int layer, int bid, int nb, char* smem) {
  const int* cnt = (const int*)(p.ws + OFF_CNT) + layer * 32;
  const int* list = (const int*)(p.ws + OFF_LIST);
  const float* mod = (const float*)(p.ws + OFF_MOD);
  const bf16_t* W2 = (const bf16_t*)(p.ws + OFF_W2T);
  const bf16_t* hid = (const bf16_t*)(p.ws + OFF_HID);
  const int TT = moe_total_tiles(cnt);
  for (int w = bid; w < TT * 8; w += nb) {
    int tg = w >> 3, nt = w & 7;
    int combo, mt, n, sbase;
    moe_find(cnt, tg, combo, mt, n, sbase);
    int e1, e2;
    combo_experts(combo, e1, e2);
    const int* lst = list + (size_t)combo * T;
    const bf16_t* Ab = hid + (size_t)(sbase + mt * 128) * 1024;
    const bf16_t* B1 = W2 + (size_t)e1 * 524288 + (size_t)nt * 128 * 512;
    const bf16_t* B2 = W2 + (size_t)e2 * 524288 + (size_t)nt * 128 * 512;
    gemm_tile([&](int i, int r, int k) { return *(const bf16x8*)(Ab + (size_t)r * 1024 + k); },
              [&](int i, int r, int k) {
                return k < 512 ? *(const bf16x8*)(B1 + (size_t)r * 512 + k)
                               : *(const bf16x8*)(B2 + (size_t)r * 512 + (k - 512));
              },
              16,
              [&](f32x4(&acc)[4][4], int r0, int c0) {
#pragma unroll
                for (int m = 0; m < 4; ++m) {
                  int slot = mt * 128 + r0 + m * 16;
                  if (slot < n) {
                    int tok = lst[slot];
                    const float* gt = mod + (size_t)(layer * 4 + (tok >> 12)) * 6144 + 5120 + nt * 128 + c0;
                    float* orow = p.out + (size_t)tok * 1024 + nt * 128 + c0;
#pragma unroll
                    for (int nn = 0; nn < 4; ++nn) {
                      float4 base = *(const float4*)(orow + nn * 4);
                      float4 g4 = *(const float4*)(gt + nn * 4);
                      base.x += g4.x * acc[m][nn][0];
                      base.y += g4.y * acc[m][nn][1];
                      base.z += g4.z * acc[m][nn][2];
                      base.w += g4.w * acc[m][nn][3];
                      *(float4*)(orow + nn * 4) = base;
                    }
                  }
                }
              },
              smem);
  }
}

namespace g8 {
struct MoeSched {
  static constexpr bool HALFSKIP = true;
  const int* cnt;
  const int* list;
  const char* A;
  const char* B;
  int nu;
  int up;
  int G, c;
  __device__ __forceinline__ bool next(int i, Unit& u) const {
    const int L = i * G + c;
    const int tg = L / nu, ng = L % nu;
    int TT = 0, NH = 0;
    for (int q = 0; q < 24; ++q) {
      const int cc = cnt[q * CNT_STRIDE];
      TT += (cc + 255) >> 8;
      NH += (cc > 0 && ((cc - 1) & 255) < 128) ? 1 : 0;
    }
    if (tg >= TT) return false;
    const int NB = TT - NH;
    int acc = 0, bacc = 0, hacc = 0, combo = -1, mt = 0, n = 0, hf = 0;
    for (int q = 0; q < 24; ++q) {
      const int cc = cnt[q * CNT_STRIDE];
      const int ntl = (cc + 255) >> 8;
      const int hq = (cc > 0 && ((cc - 1) & 255) < 128) ? 1 : 0;
      const int nbq = ntl - hq;
      if (combo < 0) {
        if (tg < NB) {
          if (tg < bacc + nbq) {
            combo = q;
            mt = tg - bacc;
            n = cc;
          }
        } else if (hq && tg - NB == hacc) {
          combo = q;
          mt = ntl - 1;
          n = cc;
          hf = 1;
        }
        if (combo < 0) {
          acc += ntl;
          bacc += nbq;
          hacc += hq;
        }
      }
    }
    if (combo < 0) return false;
    int e1, e2;
    combo_experts(combo, e1, e2);
    u.pm = mt;
    u.pn = ng;
    u.lst = list + (long)combo * T;
    u.n = n;
    u.slot0 = mt * 256;
    u.sbase = acc * 256;
    u.half = hf;
    if (up) {
      const int e = ng < 4 ? e1 : e2;
      u.aux = ng >> 2;
      u.A = A;
      u.B = B + ((long)e * 1024 + (long)(ng & 3) * 256) * 1024 * 2;
      u.bjb = 0;
    } else {
      u.aux = 0;
      u.A = A + (long)(u.sbase + u.slot0) * 1024 * 2;
      u.B = B + ((long)e1 * 1024 + (long)ng * 256) * 512 * 2;
      u.bjb = (long)(e2 - e1) * 1024 * 512 * 2 - 512 * 2;
    }
    return true;
  }
};
struct EpiMoeUp {
  static constexpr bool PERM = false;
  bf16_t* hid;
  const float* gates;
  __device__ __forceinline__ void operator()(const f32x4 (&acc)[2][2][4][2], const Unit& u, int wr, int wc, int fr,
                                             int fq) const {
    const int hc0 = u.aux * 512 + (u.pn & 3) * 128 + wc * 16 + 4 * fq;
#pragma unroll
    for (int ai = 0; ai < 2; ++ai) {
      if (ai == 1 && u.half) break;
#pragma unroll
      for (int m = 0; m < 4; ++m) {
        const int slot = u.slot0 + ai * HALF + wr * 64 + m * 16 + fr;
        const int tok = u.lst[slot < u.n ? slot : 0];
        const float gate = gates[(long)tok * 2 + u.aux];
        bf16_t* rowp = hid + (long)(u.sbase + slot) * 1024 + hc0;
#pragma unroll
        for (int bj = 0; bj < 2; ++bj) {
          const f32x4 a1 = acc[ai][bj][m][0], a3 = acc[ai][bj][m][1];
          *(uint2*)(rowp + bj * 64) = pack4(siluf_(a1[0]) * a3[0] * gate, siluf_(a1[1]) * a3[1] * gate,
                                            siluf_(a1[2]) * a3[2] * gate, siluf_(a1[3]) * a3[3] * gate);
        }
      }
    }
  }
};
struct EpiMoeDown {
  static constexpr bool PERM = false;
  float* out;
  const float* gate;
  int dry;
  __device__ __forceinline__ void operator()(const f32x4 (&acc)[2][2][4][2], const Unit& u, int wr, int wc, int fr,
                                             int fq) const {
    const int col0 = u.pn * BM + wc * 32 + 4 * fq;
#pragma unroll
    for (int ai = 0; ai < 2; ++ai)
#pragma unroll
      for (int m = 0; m < 4; ++m) {
        const int slot = u.slot0 + ai * HALF + wr * 64 + m * 16 + fr;
        if (slot < u.n) {
          const int tok = u.lst[slot];
          const float* gt = gate + (long)(tok >> 12) * 6144 + col0;
          float* orow = out + (long)tok * 1024 + col0;
#pragma unroll
          for (int bj = 0; bj < 2; ++bj)
#pragma unroll
            for (int n = 0; n < 2; ++n) {
              const f32x4 g4 = *(const f32x4*)(gt + bj * HALF + n * 16);
              const f32x4 b4 = *(const f32x4*)(orow + bj * HALF + n * 16);
              if (!dry) *(f32x4*)(orow + bj * HALF + n * 16) = b4 + g4 * acc[ai][bj][m][n];
            }
        }
      }
  }
};
}

__device__ __forceinline__ void ph8_moe_up(const P& p, int layer, LAS unsigned char* lds) {
  g8::Gemm g{1024, 1024, 1024, 1 << 20, 1 << 20, 0};
  g8::MoeSched S{(const int*)(p.ws + OFF_CNTP) + layer * CNT_LAYER, (const int*)(p.ws + OFF_LIST), (const char*)(p.ws + OFF_S1),
                 (const char*)(p.ws + (layer ? OFF_W13T_L1 : OFF_W13T)), 8, 1, (int)gridDim.x, (int)blockIdx.x};
  g8::EpiMoeUp E{(bf16_t*)(p.ws + OFF_HID), (const float*)(p.ws + OFF_GATES)};
  g8::gemm_phase<true>(lds, g, S, E);
}
__device__ __forceinline__ void ph8_moe_down(const P& p, int layer, LAS unsigned char* lds, int dry = 0) {
  g8::Gemm g{1024, 512, 1024, 1 << 20, 8, 0};
  g8::MoeSched S{(const int*)(p.ws + OFF_CNTP) + layer * CNT_LAYER, (const int*)(p.ws + OFF_LIST), (const char*)(p.ws + OFF_HID),
                 (const char*)(p.ws + (layer ? OFF_W2T_L1 : OFF_W2T)), 4, 0, (int)gridDim.x, (int)blockIdx.x};
  g8::EpiMoeDown E{p.out, (const float*)(p.ws + OFF_MOD) + (long)layer * 4 * 6144 + 5120, dry};
  g8::gemm_phase<false>(lds, g, S, E);
}

__device__ __forceinline__ void ph_norm1(const P& p, int bid, int nb, char* smem) {
  float* tb = (float*)(smem - ((tid_fresh() >> 8) * 65536));
  const float* mod = (const float*)(p.ws + OFF_MOD) + (size_t)4 * 6144;
  tok_fill_tables(tb, p.norm_w + 2 * 1024, mod, mod + 1024, nullptr, 0);
  {
    const int t = tid_fresh();
    for (int i = t; i < 3072; i += 512) tb[8192 + i] = p.mu[i];
    __syncthreads();
  }
  const int tf = tid_fresh(), lane = tf & 63, gw = (bid >> 1) * 8 + (tf >> 6), nw = (nb >> 1) * 8;
  bf16_t* hbf = (bf16_t*)(p.ws + OFF_S1);
  bf16_t* mx0 = (bf16_t*)(p.ws + OFF_KK);
  bf16_t* mx1 = (bf16_t*)(p.ws + OFF_AA);
  bf16_t* mx2 = (bf16_t*)(p.ws + OFF_G);
  auto emit = [&](int t, const float (&h)[16], const float (&hp)[16]) {
    store_hbf(hbf + (size_t)t * 1024, lane, h);
#pragma unroll
    for (int i = 0; i < 4; ++i) {
      const int d0 = (lane + 64 * i) * 4;
      const float4 mu0 = *(const float4*)(tb + 8192 + d0), mu1 = *(const float4*)(tb + 8192 + 1024 + d0),
                   mu2 = *(const float4*)(tb + 8192 + 2048 + d0);
      const float x0 = hp[i * 4] - h[i * 4], x1 = hp[i * 4 + 1] - h[i * 4 + 1], x2 = hp[i * 4 + 2] - h[i * 4 + 2],
                  x3 = hp[i * 4 + 3] - h[i * 4 + 3];
      *(uint2*)(mx0 + (size_t)t * 1024 + d0) = pack4(h[i * 4] + x0 * mu0.x, h[i * 4 + 1] + x1 * mu0.y,
                                                     h[i * 4 + 2] + x2 * mu0.z, h[i * 4 + 3] + x3 * mu0.w);
      *(uint2*)(mx1 + (size_t)t * 1024 + d0) = pack4(h[i * 4] + x0 * mu1.x, h[i * 4 + 1] + x1 * mu1.y,
                                                     h[i * 4 + 2] + x2 * mu1.z, h[i * 4 + 3] + x3 * mu1.w);
      *(uint2*)(mx2 + (size_t)t * 1024 + d0) = pack4(h[i * 4] + x0 * mu2.x, h[i * 4 + 1] + x1 * mu2.y,
                                                     h[i * 4 + 2] + x2 * mu2.z, h[i * 4 + 3] + x3 * mu2.w);
    }
  };
  for (int ch = gw; ch < T / 8; ch += nw) {
    const int t0 = ch * 8, b = t0 >> 12;
    const bool first = (t0 & (SEQ - 1)) == 0;
    float hc[16];
#pragma unroll
    for (int j = 0; j < 16; ++j) hc[j] = 0.f;
#pragma unroll 1
    for (int k = 0; k < 5; ++k) {
      int ra = t0 - 1 + 2 * k, rb = t0 + 2 * k;
      if (k == 0 && first) ra = t0;
      if (k == 4) rb = t0 + 7;
      float ha[16], hb[16];
      norm2(p.out + (size_t)ra * 1024, p.out + (size_t)rb * 1024, tb, b, lane, ha, hb);
      if (k == 0 && first) {
#pragma unroll
        for (int j = 0; j < 16; ++j) ha[j] = 0.f;
      }
      if (k >= 1) emit(ra, ha, hc);
      if (k <= 3) emit(rb, hb, ha);
#pragma unroll
      for (int j = 0; j < 16; ++j) hc[j] = hb[j];
    }
  }
}

__device__ __forceinline__ void ph_gemm_rkv(const P& p, int bid, int nb, char* smem) {
  const bf16_t* hbf = (const bf16_t*)(p.ws + OFF_S1);
  const bf16_t* W = (const bf16_t*)(p.ws + OFF_WRKVT);
  const bf16_t* L1T = (const bf16_t*)(p.ws + OFF_LORA1T);
  bf16_t* lora1 = (bf16_t*)(p.ws + OFF_LORA1);
  const int kh = bid & 1;
  char* base_lds = smem - kh * 65536;
  float* sums = (float*)(base_lds + 65536);
  for (int w = bid >> 1; w < 128 * 2; w += nb >> 1) {
    int mt = w % 128, nt = w / 128 + 24;
    const int m0 = mt * 128;
    {
      const int n0 = (nt - 24) * 128;
      const bf16_t* Bb = L1T + (size_t)n0 * 2048 + kh * 1024;
      gemm_tile(
          [&](int i, int r, int k) {
            int t = m0 + r;
            bf16x8 v = *(const bf16x8*)(hbf + ((long)t - kh) * 1024 + k);
            if (kh && (t & (SEQ - 1)) == 0) v = (bf16x8){0, 0, 0, 0, 0, 0, 0, 0};
            return v;
          },
          [&](int i, int r, int k) { return *(const bf16x8*)(Bb + (size_t)r * 2048 + k); }, 16,
          [&](f32x4(&acc)[4][4], int r0, int c0) {
            const int tl = TIDX;
            __syncthreads();
            if (kh == 1) {
#pragma unroll
              for (int m = 0; m < 4; ++m)
#pragma unroll
                for (int n = 0; n < 4; ++n) *(f32x4*)(sums + ((m * 4 + n) * 256 + tl) * 4) = acc[m][n];
            }
            __syncthreads();
            if (kh == 0) {
              const int colb = n0 + c0;
#pragma unroll
              for (int m = 0; m < 4; ++m) {
#pragma unroll
                for (int n = 0; n < 4; ++n) {
                  const f32x4 o = *(const f32x4*)(sums + ((m * 4 + n) * 256 + tl) * 4);
#pragma unroll
                  for (int j = 0; j < 4; ++j) {
                    float v = acc[m][n][j] + o[j];
                    acc[m][n][j] = colb < 64 ? 1.f - 2.f / (__expf(2.f * v) + 1.f) : (colb < 128 ? v : sigmoidf_(v));
                  }
                }
                store16(lora1 + (size_t)(m0 + r0 + m * 16) * 256 + colb, acc[m]);
              }
            }
          },
          smem);
    }
  }
}

__device__ __forceinline__ void ph_gemm_lora2(const P& p, int bid, int nb, char* smem) {
  const bf16_t* lora1 = (const bf16_t*)(p.ws + OFF_LORA1);
  float* wdec = (float*)(p.ws + OFF_S2);
  bf16_t* aa = (bf16_t*)(p.ws + OFF_AA);
  bf16_t* gg = (bf16_t*)(p.ws + OFF_G);
  for (int w = bid; w < 128 * 24; w += nb) {
    int mt = w % 128, rest = w / 128, which = rest >> 3, nt = rest & 7;
    const int m0 = mt * 128, n0 = nt * 128;
    const int K = which == 2 ? 128 : 64;
    const int aoff = which == 0 ? 0 : (which == 1 ? 64 : 128);
    const bf16_t* Bt = (const bf16_t*)(p.ws + (which == 0 ? OFF_DEC2T : (which == 1 ? OFF_A2T : OFF_G2T)));
    const bf16_t* Ab = lora1 + (size_t)m0 * 256 + aoff;
    const bf16_t* Bb = Bt + (size_t)n0 * K;
    gemm_tile([&](int i, int r, int k) { return *(const bf16x8*)(Ab + (size_t)r * 256 + k); },
              [&](int i, int r, int k) { return *(const bf16x8*)(Bb + (size_t)r * K + k); }, K / 64,
              [&](f32x4(&acc)[4][4], int r0, int c0) {
#pragma unroll
                for (int m = 0; m < 4; ++m) {
                  const int col = n0 + c0;
                  const size_t idx = (size_t)(m0 + r0 + m * 16) * 1024 + col;
                  if (which == 0) {
#pragma unroll
                    for (int n = 0; n < 4; ++n) {
                      float4 o;
                      float* op = (float*)&o;
#pragma unroll
                      for (int j = 0; j < 4; ++j) {
                        float wl = -__logf(1.f + __expf(-(p.dec0[col + n * 4 + j] + acc[m][n][j]))) - 0.5f;
                        op[j] = __expf(-__expf(wl));
                      }
                      *(float4*)(wdec + idx + n * 4) = o;
                    }
                  } else if (which == 1) {
#pragma unroll
                    for (int n = 0; n < 4; ++n)
#pragma unroll
                      for (int j = 0; j < 4; ++j) acc[m][n][j] = sigmoidf_(p.a0[col + n * 4 + j] + acc[m][n][j]);
                    store16(aa + idx, acc[m]);
                  } else {
                    store16(gg + idx, acc[m]);
                  }
                }
              },
              smem);
  }
}

__device__ __forceinline__ void ph_prep1(const P& p, int bid, int nb) {
  const int lane = TIDX & 63, wid = TIDX >> 6;
  const bf16_t* R = (const bf16_t*)(p.ws + OFF_R);
  bf16_t* Kb = (bf16_t*)(p.ws + OFF_K);
  bf16_t* KK = (bf16_t*)(p.ws + OFF_KK);
  const bf16_t* AA = (const bf16_t*)(p.ws + OFF_AA);
  float* bonus = (float*)(p.ws + OFF_BONUS);
  const int c0 = lane * 16;
  for (int t = bid * 4 + wid; t < T; t += nb * 4) {
    size_t base = (size_t)t * 1024 + c0;
    float kv[16], av[16], rv[16];
#pragma unroll
    for (int i = 0; i < 2; ++i) {
      bf16x8 k8 = *(const bf16x8*)(Kb + base + i * 8), a8 = *(const bf16x8*)(AA + base + i * 8),
             r8 = *(const bf16x8*)(R + base + i * 8);
#pragma unroll
      for (int j = 0; j < 8; ++j) {
        kv[i * 8 + j] = bfs2f(k8[j]);
        av[i * 8 + j] = bfs2f(a8[j]);
        rv[i * 8 + j] = bfs2f(r8[j]);
      }
    }
    float kkv[16], kh[16];
    float ss = 0.f, bon = 0.f;
#pragma unroll
    for (int j = 0; j < 16; ++j) {
      kkv[j] = kv[j] * p.k_k[c0 + j];
      ss += kkv[j] * kkv[j];
      kh[j] = kv[j] * (1.f + (av[j] - 1.f) * p.k_a[c0 + j]);
      bon += rv[j] * kh[j] * p.r_k[c0 + j];
    }
    ss += __shfl_xor(ss, 1, 64);
    ss += __shfl_xor(ss, 2, 64);
    bon += __shfl_xor(bon, 1, 64);
    bon += __shfl_xor(bon, 2, 64);
    float inv = 1.f / fmaxf(sqrtf(ss), 1e-12f);
#pragma unroll
    for (int i = 0; i < 2; ++i) {
      bf16x8 o1, o2;
#pragma unroll
      for (int j = 0; j < 8; ++j) {
        o1[j] = (short)f2bf(kkv[i * 8 + j] * inv);
        o2[j] = (short)f2bf(kh[i * 8 + j]);
      }
      *(bf16x8*)(KK + base + i * 8) = o1;
      *(bf16x8*)(Kb + base + i * 8) = o2;
    }
    if ((lane & 3) == 0) bonus[(size_t)t * 16 + (lane >> 2)] = bon;
  }
}

struct ScanRegs {
  bf16x4 r, k, a;
  f32x4 w;
  bf16_t v;
};
constexpr int SCAN_STEP = 336;

__device__ __forceinline__ void scan1_unit(const P& p, int u, char* smem) {
  const int tfull = tid_fresh();
  const bool loader = (tfull >> 8) != 0;
  const int tid = tfull & 255, lane = tid & 63, w = tid >> 6;
  const int bh = u >> 2, rg = u & 3, b = bh >> 4, hd = bh & 15;
  const bf16_t* R = (const bf16_t*)(p.ws + OFF_R);
  bf16_t* Yo = (bf16_t*)(p.ws + OFF_S1);
  const bf16_t* Kb = (const bf16_t*)(p.ws + OFF_K);
  const bf16_t* V = (const bf16_t*)(p.ws + OFF_V);
  const bf16_t* AA = (const bf16_t*)(p.ws + OFF_AA);
  const float* W = (const float*)(p.ws + OFF_S2);
  float* bonus = (float*)(p.ws + OFF_BONUS);
  float* buf0 = (float*)smem;
  float* buf1 = buf0 + 16 * SCAN_STEP;
  float* yb0 = buf1 + 16 * SCAN_STEP;
  float* yb1 = yb0 + 256;
  const int ks = (lane & 15) * 4, rl = w * 4 + (lane >> 4);
  const int st_l = tid >> 4, k0 = (tid & 15) * 4, rr = tid & 15;
  const size_t gbase = (size_t)b * SEQ * 1024 + hd * 64;
  if (loader) {
    const f32x4 kkp = *(const f32x4*)(p.k_k + hd * 64 + k0), kap = *(const f32x4*)(p.k_a + hd * 64 + k0),
                rkp = *(const f32x4*)(p.r_k + hd * 64 + k0);
    auto gload = [&](int t0, ScanRegs& g) {
      const size_t o = gbase + (size_t)(t0 + st_l) * 1024;
      g.r = *(const bf16x4*)(R + o + k0);
      g.k = *(const bf16x4*)(Kb + o + k0);
      g.a = *(const bf16x4*)(AA + o + k0);
      g.w = *(const f32x4*)(W + o + k0);
      g.v = V[o + rg * 16 + rr];
    };
    auto lwrite = [&](float* buf, const ScanRegs& g, int t0) {
      float* d = buf + st_l * SCAN_STEP;
      f32x4 rf, kf, af;
#pragma unroll
      for (int j = 0; j < 4; ++j) {
        rf[j] = bfs2f(g.r[j]);
        kf[j] = bfs2f(g.k[j]);
        af[j] = bfs2f(g.a[j]);
      }
      const f32x4 kkv = kf * kkp;
      const f32x4 kh = kf * ((af - 1.f) * kap + 1.f);
      const f32x4 sq = kkv * kkv, bq = rf * kh * rkp;
      float ss = (sq[0] + sq[1]) + (sq[2] + sq[3]);
      float bon = (bq[0] + bq[1]) + (bq[2] + bq[3]);
      ss = row16_sum(ss);
      bon = row16_sum(bon);
      const float inv = 1.f / fmaxf(sqrtf(ss), 1e-12f);
      const f32x4 r4 = rf, k4 = kh, n4 = kkv * (-inv), b4 = kkv * af * inv;
      *(f32x4*)(d + k0) = r4;
      *(f32x4*)(d + 64 + k0) = g.w;
      *(f32x4*)(d + 128 + k0) = k4;
      *(f32x4*)(d + 192 + k0) = n4;
      *(f32x4*)(d + 256 + k0) = b4;
      d[320 + rr] = bf2f(g.v);
      if (rg == 0 && rr == 0) bonus[((size_t)b * SEQ + t0 + st_l) * 16 + hd] = bon;
    };
    auto ystore = [&](int t0, const float* yb) {
      Yo[gbase + (size_t)(t0 + st_l) * 1024 + rg * 16 + rr] = f2bf(yb[st_l * 16 + rr]);
    };
    float* ctile = (float*)(smem + 65536) + w * (64 * 33);
    const float* cw1 = p.moe_w1 + (size_t)16 * 524288;
    const float* cw3 = p.moe_w3 + (size_t)16 * 524288;
    const float* cw2 = p.moe_w2 + (size_t)16 * 524288;
    bf16_t* cd13 = (bf16_t*)(p.ws + OFF_W13T_L1);
    bf16_t* cd2 = (bf16_t*)(p.ws + OFF_W2T_L1);
    constexpr int CNT = 16 * 768;
    const int clr = lane >> 3, clc = (lane & 7) * 4, ckc = lane & 7;
    auto cload = [&](int gi, f32x4 (&v)[8]) {
      const int e = gi / 768, r = gi - e * 768, which = r >> 8, tt = r & 255;
      const float* src = (which == 0 ? cw1 : (which == 1 ? cw3 : cw2)) + (size_t)e * 524288;
      const int ld = which == 2 ? 1024 : 512;
      const int k0c = which == 2 ? (tt >> 5) * 64 : (tt >> 4) * 64, n0c = which == 2 ? (tt & 31) * 32 : (tt & 15) * 32;
#pragma unroll
      for (int i = 0; i < 8; ++i) v[i] = *(const f32x4*)(src + (size_t)(k0c + clr + 8 * i) * ld + n0c + clc);
    };
    auto cstore = [&](int gi, const f32x4 (&v)[8]) {
      const int e = gi / 768, r = gi - e * 768, which = r >> 8, tt = r & 255;
      const int k0c = which == 2 ? (tt >> 5) * 64 : (tt >> 4) * 64, n0c = which == 2 ? (tt & 31) * 32 : (tt & 15) * 32;
#pragma unroll
      for (int i = 0; i < 8; ++i) {
        float* d = ctile + (clr + 8 * i) * 33 + clc;
        d[0] = v[i][0];
        d[1] = v[i][1];
        d[2] = v[i][2];
        d[3] = v[i][3];
      }
      __builtin_amdgcn_wave_barrier();
#pragma unroll
      for (int q = 0; q < 4; ++q) {
        const int n = n0c + (lane >> 3) + 8 * q;
        bf16_t* drow = which == 2 ? cd2 + (size_t)e * 524288 + (size_t)n * 512 + k0c
                                  : cd13 + (size_t)e * 1048576 + (size_t)((n >> 4) * 32 + which * 16 + (n & 15)) * 1024 + k0c;
        const float* tq = ctile + ckc * 8 * 33 + (lane >> 3) + 8 * q;
        const bf16x8 o = pack8(tq[0], tq[33], tq[66], tq[99], tq[132], tq[165], tq[198], tq[231]);
        *(bf16x8*)(drow + ckc * 8) = o;
      }
      __builtin_amdgcn_wave_barrier();
    };
    int cg = (int)blockIdx.x * 4 + w;
    bool cpend = false;
    f32x4 cva[8];
    ScanRegs g0, g1;
    gload(0, g0);
    __syncthreads();
    lwrite(buf0, g0, 0);
    gload(16, g0);
    gload(32, g1);
    __syncthreads();
    auto liter = [&](int bt, ScanRegs& g) {
      float* nb_ = (bt & 1) ? buf0 : buf1;
      float* yprev = (bt & 1) ? yb0 : yb1;
      if (bt + 1 < 256) lwrite(nb_, g, (bt + 1) * 16);
      if (bt + 3 < 256) gload((bt + 3) * 16, g);
      if (bt > 0) ystore((bt - 1) * 16, yprev);
      if ((bt & 7) == 6 && cpend) {
        cstore(cg, cva);
        cpend = false;
        cg += 1024;
      }
      if ((bt & 7) == 2 && cg < CNT) {
        cload(cg, cva);
        cpend = true;
      }
      __syncthreads();
    };
#pragma unroll 1
    for (int bt = 0; bt < 256; bt += 2) {
      liter(bt, g0);
      liter(bt + 1, g1);
    }
    ystore(255 * 16, yb1);
    while (cg < CNT) {
      cload(cg, cva);
      cstore(cg, cva);
      cg += 1024;
    }
  } else {
    f32x2 S01 = {0.f, 0.f}, S23 = {0.f, 0.f};
    auto compute = [&](const float* buf, float* yb) {
      const float* sp0 = buf + ks;
      f32x4 nk = *(const f32x4*)(sp0 + 192), wv = *(const f32x4*)(sp0 + 64), kv = *(const f32x4*)(sp0 + 128),
            bt = *(const f32x4*)(sp0 + 256), rv = *(const f32x4*)(sp0);
      float vv = buf[320 + rl];
      float ykeep = 0.f;
#pragma unroll 4
      for (int st = 0; st < 16; ++st) {
        const float* sp = sp0 + (st + 1) * SCAN_STEP;
        f32x4 nk2 = *(const f32x4*)(sp + 192), wv2 = *(const f32x4*)(sp + 64), kv2 = *(const f32x4*)(sp + 128),
              bt2 = *(const f32x4*)(sp + 256), rv2 = *(const f32x4*)(sp);
        float vv2 = buf[(st + 1) * SCAN_STEP + 320 + rl];
        const f32x2 vvv = {vv, vv};
        f32x2 pa = S01 * nk.xy;
        pa = S23 * nk.zw + pa;
        f32x2 t01 = S01 * wv.xy, t23 = S23 * wv.zw;
        t01 = vvv * kv.xy + t01;
        t23 = vvv * kv.zw + t23;
        const float sa = row16_sum(pa.x + pa.y);
        const f32x2 sav = {sa, sa};
        S01 = sav * bt.xy + t01;
        S23 = sav * bt.zw + t23;
        f32x2 qy = S01 * rv.xy;
        qy = S23 * rv.zw + qy;
        const float y = row16_sum(qy.x + qy.y);
        ykeep = ((lane & 15) == st) ? y : ykeep;
        asm volatile("" : "+v"(nk2), "+v"(wv2), "+v"(kv2), "+v"(bt2), "+v"(rv2), "+v"(vv2));
        nk = nk2; wv = wv2; kv = kv2; bt = bt2; rv = rv2; vv = vv2;
      }
      yb[(lane & 15) * 16 + rl] = ykeep;
    };
    __syncthreads();
    __syncthreads();
    __builtin_amdgcn_s_setprio(3);
    for (int bt = 0; bt < 256; ++bt) {
      compute((bt & 1) ? buf1 : buf0, (bt & 1) ? yb1 : yb0);
      __syncthreads();
    }
    __builtin_amdgcn_s_setprio(0);
  }
}

__device__ __forceinline__ void ph_scan1(const P& p, int bid, int nb, char* smem) {
  const int c = (int)blockIdx.x;
  if (c < 256) {
    const int x = c & 7, j = c >> 3;
    const int u = ((x + 8 * (j >> 2)) << 2) | (j & 3);
    scan1_unit(p, u, smem - ((tid_fresh() >> 8) * 65536));
  }
}

__device__ __forceinline__ void ph_post1(const P& p, int bid, int nb) {
  const int lane = TIDX & 63, wid = TIDX >> 6;
  const bf16_t* Y = (const bf16_t*)(p.ws + OFF_S1);
  const bf16_t* V = (const bf16_t*)(p.ws + OFF_V);
  const bf16_t* G = (const bf16_t*)(p.ws + OFF_G);
  const float* bonus = (const float*)(p.ws + OFF_BONUS);
  bf16_t* o = (bf16_t*)(p.ws + OFF_S1);
  const int c0 = lane * 16;
  for (int t = bid * 4 + wid; t < T; t += nb * 4) {
    size_t base = (size_t)t * 1024 + c0;
    float yv[16], vv[16], gv[16];
    float s = 0.f;
#pragma unroll
    for (int i = 0; i < 2; ++i) {
      bf16x8 y8 = *(const bf16x8*)(Y + base + i * 8), v8 = *(const bf16x8*)(V + base + i * 8),
             g8 = *(const bf16x8*)(G + base + i * 8);
#pragma unroll
      for (int j = 0; j < 8; ++j) {
        yv[i * 8 + j] = bfs2f(y8[j]);
        vv[i * 8 + j] = bfs2f(v8[j]);
        gv[i * 8 + j] = bfs2f(g8[j]);
        s += yv[i * 8 + j];
      }
    }
    s += __shfl_xor(s, 1, 64);
    s += __shfl_xor(s, 2, 64);
    float mean = s * (1.f / 64.f);
    float var = 0.f;
#pragma unroll
    for (int j = 0; j < 16; ++j) var += (yv[j] - mean) * (yv[j] - mean);
    var += __shfl_xor(var, 1, 64);
    var += __shfl_xor(var, 2, 64);
    float rstd = rsqrtf(var * (1.f / 64.f) + 64e-5f);
    float bon = bonus[(size_t)t * 16 + (lane >> 2)];
#pragma unroll
    for (int i = 0; i < 2; ++i) {
      bf16x8 o8;
#pragma unroll
      for (int j = 0; j < 8; ++j) {
        int c = c0 + i * 8 + j;
        float val = (yv[i * 8 + j] - mean) * rstd * p.ln_w[c] + p.ln_b[c] + bon * vv[i * 8 + j];
        o8[j] = (short)f2bf(val * gv[i * 8 + j]);
      }
      *(bf16x8*)(o + base + i * 8) = o8;
    }
  }
}

__device__ __forceinline__ void ph_final(const P& p, int bid, int nb) {
  const int lane = TIDX & 63, wid = TIDX >> 6;
  for (int t = bid * 4 + wid; t < T; t += nb * 4) {
    float4* xr = (float4*)(p.out + (size_t)t * 1024);
    float4 v[4];
    float ss = 0;
#pragma unroll
    for (int i = 0; i < 4; ++i) {
      v[i] = xr[lane + 64 * i];
      ss += v[i].x * v[i].x + v[i].y * v[i].y + v[i].z * v[i].z + v[i].w * v[i].w;
    }
    ss = wave_sum(ss);
    float rstd = rsqrtf(ss * (1.f / 1024.f) + 1e-6f);
    if (PROBE_MASK != 0) {
      const unsigned long long* ts = (const unsigned long long*)(p.ws + OFF_TS);
      unsigned long long sel = 0;
#pragma unroll
      for (int k = 0; k < 21; ++k)
        if ((PROBE_MASK >> k) & 1) sel += ts[k + 1] - ts[k];
      rstd *= 1.f + 10.f * ((float)sel / (float)(ts[21] - ts[0]));
    }
#pragma unroll
    for (int i = 0; i < 4; ++i) {
      float4 w4 = *(const float4*)(p.final_w + (lane + 64 * i) * 4);
      float4 o;
      o.x = v[i].x * rstd * w4.x;
      o.y = v[i].y * rstd * w4.y;
      o.z = v[i].z * rstd * w4.z;
      o.w = v[i].w * rstd * w4.w;
      xr[lane + 64 * i] = o;
    }
  }
}


#define AS1 __attribute__((address_space(1)))
template <int PH, class T>
__device__ __forceinline__ T* launder(T* ptr) {
  AS1 T* g = (AS1 T*)ptr;
  asm("; phase %1" : "+s"(g) : "i"(PH));
  return (T*)g;
}
template <int PH>
__device__ __forceinline__ P launder_params(const P& q) {
  P r;
  const float* const* src = (const float* const*)&q;
  const float** dst = (const float**)&r;
#pragma unroll
  for (int i = 0; i < 37; ++i) dst[i] = launder<PH>(src[i]);
  r.out = launder<PH>(q.out);
  r.ws = launder<PH>(q.ws);
  return r;
}

constexpr int NPHASE = 25;
template <int PH>
__device__ __forceinline__ void run_phase(const P& p0, int bid, int nb, char* smem, LAS unsigned char* lds) {
  const P p = launder_params<PH>(p0);
  const float* mod = (const float*)(p.ws + OFF_MOD);
  if (PH == 0) { ph_prep(p, bid, nb, smem); __syncthreads(); ph_conv_w0(p, bid, nb, smem); __syncthreads(); }
  else if (PH == 1) ph_norm0(p, bid, nb, smem);
  else if (PH == 2) ph8_inproj(p, lds);
  else if (PH == 3) {}
  else if (PH == 4) ph_mixA(p, bid, nb, smem);
  else if (PH == 5) ph_mixS(p, bid, nb);
  else if (PH == 21) ph_mixB(p, bid, nb, smem, 0);
  else if (PH == 6) ph8_outproj(p, lds);
  else if (PH == 7) { ph_route(p, 0, bid, nb, smem); __syncthreads(); ph_conv_moe(p, 0, bid, nb, smem); ph_conv_w1(p, bid, nb, smem); __syncthreads(); }
  else if (PH == 8) ph8_moe_up(p, 0, lds);
  else if (PH == 9) ph8_moe_down(p, 0, lds);
  else if (PH == 10) ph_norm1(p, bid, nb, smem);
  else if (PH == 11) { ph8_rkv(p, lds); ph_gemm_rkv(p, bid, nb, smem); }
  else if (PH == 12) ph_gemm_lora2(p, bid, nb, smem);
  else if (PH == 13) {}
  else if (PH == 14) ph_scan1(p, bid, nb, smem);
  else if (PH == 15) ph_post1(p, bid, nb);
  else if (PH == 16) ph8_wo(p, lds);
  else if (PH == 17) { ph_route(p, 1, bid, nb, smem); }
  else if (PH == 18) ph8_moe_up(p, 1, lds);
  else if (PH == 19) ph8_moe_down(p, 1, lds);
  else if (PH == 20) ph_final(p, bid, nb);
}

#define XB_TMO      128
#define XB_XCNT(j)  (256  + 64 * (j))
#define XB_XSUB(j)  (1280 + 64 * (j))
#define XB_XGEN(j)  (2304 + 64 * (j))
#define XB_TOP      3328
#define XB_TOPGEN   3392
#define XCD_BAR_WORDS 3456
#define XB_SPIN_CAP (1u << 18)

__device__ __forceinline__ unsigned xb_ld(unsigned* p)              { return __hip_atomic_load(p, __ATOMIC_RELAXED, __HIP_MEMORY_SCOPE_AGENT); }
__device__ __forceinline__ unsigned xb_add(unsigned* p, unsigned v) { return __hip_atomic_fetch_add(p, v, __ATOMIC_RELAXED, __HIP_MEMORY_SCOPE_AGENT); }
__device__ __forceinline__ unsigned xb_xcc_id() { return (unsigned)__builtin_amdgcn_s_getreg((3 << 11) | 20) & 0xFu; }
#define XB_SPIN(cond, bar) do { unsigned _sp = 0; while (cond) { __builtin_amdgcn_s_sleep(1); \
    if ((++_sp & 255u) == 0u) { if (xb_ld(&(bar)[XB_TMO])) break; if (_sp > XB_SPIN_CAP) { atomicAdd(&(bar)[XB_TMO], 1u); break; } } } } while (0)

struct XcdBarrier {
    unsigned* bar; unsigned x;
    volatile LAS unsigned* st;
};

__device__ __forceinline__ XcdBarrier xcd_barrier_post(unsigned* bar, volatile LAS unsigned* st) {
    XcdBarrier b; b.bar = bar; b.x = xb_xcc_id(); b.st = st;
    if (threadIdx.x == 0) (void)xb_add(&bar[XB_XCNT(b.x)], 1u);
    return b;
}
__device__ __forceinline__ void xcd_barrier_complete(unsigned* bar, unsigned x, unsigned& nloc, unsigned& nx) {
    const unsigned G = gridDim.x * gridDim.y * gridDim.z;
    unsigned sum, cnt, mine, sp = 0u;
    for (;;) {
        sum = 0u; cnt = 0u; mine = 0u;
#pragma unroll
        for (unsigned j = 0; j < 16; ++j) { const unsigned c = xb_ld(&bar[XB_XCNT(j)]); sum += c; cnt += (c > 0u) ? 1u : 0u; mine = (j == x) ? c : mine; }
        if (sum == G) break;
        __builtin_amdgcn_s_sleep(1);
        if ((++sp & 255u) == 0u) { if (xb_ld(&bar[XB_TMO])) break; if (sp > XB_SPIN_CAP) { atomicAdd(&bar[XB_TMO], 1u); break; } }
    }
    nloc = mine > 0u ? mine : 1u; nx = cnt > 0u ? cnt : 1u;
}

__device__ __forceinline__ void xcd_barrier(const XcdBarrier& b) {
    asm volatile("s_waitcnt vmcnt(0)" ::: "memory");
    __syncthreads();
    if (threadIdx.x == 0) {
        unsigned* bar = b.bar;
        __builtin_amdgcn_s_waitcnt(0);
        unsigned nloc = b.st[0], nx = b.st[1];
        if (nloc == 0u) { xcd_barrier_complete(bar, b.x, nloc, nx); b.st[0] = nloc; b.st[1] = nx; }
        const unsigned old = xb_add(&bar[XB_XSUB(b.x)], 1u);
        const unsigned gen = old / nloc;
        if (old + 1u == (gen + 1u) * nloc) {
            __builtin_amdgcn_fence(__ATOMIC_RELEASE, "agent");
            asm volatile("s_waitcnt vmcnt(0)" ::: "memory");
            const unsigned og = xb_add(&bar[XB_TOP], 1u);
            const unsigned tg = og / nx;
            if (og + 1u == (tg + 1u) * nx) xb_add(&bar[XB_TOPGEN], 1u);
            else XB_SPIN(xb_ld(&bar[XB_TOPGEN]) == tg, bar);
            __builtin_amdgcn_fence(__ATOMIC_ACQUIRE, "agent");
            xb_add(&bar[XB_XGEN(b.x)], 1u);
            asm volatile("s_waitcnt vmcnt(0)" ::: "memory");
        } else {
            XB_SPIN(xb_ld(&bar[XB_XGEN(b.x)]) == gen, bar);
            __builtin_amdgcn_fence(__ATOMIC_ACQUIRE, "agent");
            asm volatile("s_waitcnt vmcnt(0)" ::: "memory");
        }
    }
    __syncthreads();
}


namespace cg = cooperative_groups;

__device__ __forceinline__ void probe_stamp(const P& p, int slot) {
  if (PROBE_MASK != 0 && blockIdx.x == 0 && threadIdx.x == 0) {
    unsigned long long* ts = (unsigned long long*)(p.ws + OFF_TS);
    ts[slot] = wall_clock64();
  }
}


template <int PH, int SLOT>
__device__ __forceinline__ void run_all(const P& p, int bid, int nb, char* smem, LAS unsigned char* lds, const XcdBarrier& xb) {
  if constexpr (PH == 13 || PH == 3) {
    run_all<PH + 1, SLOT + 1>(p, bid, nb, smem, lds, xb);
  } else if constexpr (PH < 21) {
    run_phase<PH>(p, bid, nb, smem, lds);
    if constexpr (PH < 20) {
      if constexpr (PH == 19) probe_stamp(p, SLOT + 1);
      xcd_barrier(xb);
      if constexpr (PH != 19) probe_stamp(p, SLOT + 1);
    }
    if constexpr (PH == 5) {
      run_phase<21>(p, bid, nb, smem, lds);
      xcd_barrier(xb);
      probe_stamp(p, SLOT + 2);
      run_all<PH + 1, SLOT + 2>(p, bid, nb, smem, lds, xb);
    } else {
      run_all<PH + 1, SLOT + 1>(p, bid, nb, smem, lds, xb);
    }
  }
}

constexpr int DYN_LDS = 131072 + 64;

__global__ void __launch_bounds__(512, 2) mega(P p) {
  extern __shared__ __attribute__((aligned(16))) char dsm[];
  if (p.ws == nullptr) cg::this_grid().sync();
  volatile LAS unsigned* st = (volatile LAS unsigned*)(dsm + 131072);
  if (threadIdx.x == 0) {
    st[0] = 0u;
    st[1] = 0u;
    st[2] = 0u;
    st[3] = 0u;
  }
  __syncthreads();
  XcdBarrier xb = xcd_barrier_post((unsigned*)(p.ws + OFF_BAR), st);
  probe_stamp(p, 0);
  const int vb = threadIdx.x >> 8;
  run_all<0, 0>(p, (int)blockIdx.x * 2 + vb, (int)gridDim.x * 2, dsm + vb * 65536, (LAS unsigned char*)dsm, xb);
}

extern "C" void kernel_launch(void* const* d_in, const int* in_sizes, int n_in, void* d_out, int out_size, void* d_ws,
                              size_t ws_size, hipStream_t stream) {
  P p{};
  const float** pp = (const float**)&p;
  for (int i = 0; i < 37; ++i) pp[i] = (const float*)d_in[i];
  p.out = (float*)d_out;
  p.ws = (char*)d_ws;
  if (ws_size < WS_NEED) fprintf(stderr, "workspace too small: %zu < %zu\n", ws_size, (size_t)WS_NEED);
  static int grid_blocks = 0;
  if (!grid_blocks) {
    int dev = 0, cus = 0, per_cu = 0;
    hipGetDevice(&dev);
    hipDeviceGetAttribute(&cus, hipDeviceAttributeMultiprocessorCount, dev);
    hipFuncSetAttribute((const void*)mega, hipFuncAttributeMaxDynamicSharedMemorySize, DYN_LDS);
    hipOccupancyMaxActiveBlocksPerMultiprocessor(&per_cu, mega, 512, DYN_LDS);
    if (per_cu > 1) per_cu = 1;
    if (per_cu < 1) per_cu = 1;
    grid_blocks = cus * per_cu;
  }
  hipMemsetAsync((char*)d_ws + OFF_BAR, 0, BAR_MEMSET_BYTES, stream);
  void* args[] = {&p};
  hipError_t e = hipLaunchCooperativeKernel((void*)mega, dim3(grid_blocks), dim3(512), args, DYN_LDS, stream);
  if (e != hipSuccess) fprintf(stderr, "cooperative launch failed: %s (grid %d)\n", hipGetErrorString(e), grid_blocks);
}
```

```cpp
#include <hip/hip_runtime.h>
#include <hip/hip_cooperative_groups.h>
#include <stdint.h>
#include <stdio.h>

typedef unsigned short bf16_t;
typedef __attribute__((ext_vector_type(8))) short bf16x8;
typedef __attribute__((ext_vector_type(4))) short bf16x4;
typedef __attribute__((ext_vector_type(4))) float f32x4;
typedef __attribute__((ext_vector_type(2))) float f32x2;

constexpr int T = 16384;
constexpr int SEQ = 4096;
constexpr int NPROJ = 6656;

constexpr size_t MiB = 1048576;
constexpr size_t OFF_MOD = 0;
constexpr size_t OFF_LB = 196608;
constexpr size_t OFF_CNT = 200704;
constexpr size_t OFF_CNTP = 6 * (size_t)(1 << 20) + 65536;
constexpr int CNT_STRIDE = 64, CNT_LAYER = 2048;
constexpr size_t OFF_DT = 200960;
constexpr size_t OFF_GATES = OFF_DT + (size_t)T * 16 * 4;
constexpr size_t OFF_BONUS = OFF_GATES + (size_t)T * 2 * 4;
constexpr size_t OFF_LIST = OFF_BONUS + (size_t)T * 16 * 4;
constexpr size_t OFF_WA = 8 * MiB;
constexpr size_t OFF_S1 = 28 * MiB;
constexpr size_t OFF_S2 = 60 * MiB;
constexpr size_t OFF_BIG = 124 * MiB;
constexpr size_t WS_NEED = 340 * MiB;
constexpr size_t OFF_WOUTT = OFF_WA;
constexpr size_t OFF_WINT = OFF_WA + 4 * MiB;
constexpr size_t OFF_WRKVT = OFF_WA;
constexpr size_t OFF_WOT = OFF_WA + 6 * MiB;
constexpr size_t OFF_LORA1T = OFF_WA + 8 * MiB;
constexpr size_t OFF_DEC2T = OFF_WA + 9 * MiB;
constexpr size_t OFF_A2T = OFF_DEC2T + 131072;
constexpr size_t OFF_G2T = OFF_A2T + 131072;
constexpr size_t OFF_PROJ = OFF_BIG;
constexpr size_t OFF_W13T = OFF_BIG;
constexpr size_t OFF_W2T = OFF_BIG + 32 * MiB;
constexpr size_t OFF_HID = OFF_BIG + 48 * MiB;
constexpr size_t OFF_W13T_L1 = OFF_BIG + 96 * MiB;
constexpr size_t OFF_W2T_L1 = OFF_BIG + 200 * MiB;
constexpr size_t OFF_R = OFF_BIG;
constexpr size_t OFF_K = OFF_BIG + 32 * MiB;
constexpr size_t OFF_V = OFF_BIG + 64 * MiB;
constexpr size_t OFF_KK = OFF_BIG + 96 * MiB;
constexpr size_t OFF_AA = OFF_BIG + 128 * MiB;
constexpr size_t OFF_G = OFF_BIG + 160 * MiB;
constexpr size_t OFF_LORA1 = OFF_BIG + 192 * MiB;

struct P {
  const float *x, *c, *mod_w, *mod_b, *norm_w, *lb_logits, *w_in, *hg_norm, *conv_w, *conv_b, *dt_bias, *a_log,
      *d_skip, *ssm_norm, *w_out, *mu, *w_rkv, *dec0, *dec1, *dec2, *a0, *a1, *a2, *g1, *g2, *k_k, *k_a, *r_k,
      *ln_w, *ln_b, *w_o, *router_w, *router_b, *moe_w1, *moe_w3, *moe_w2, *final_w;
  float* out;
  char* ws;
};

#define PROBE_MASK 0
constexpr size_t OFF_TS = 6 * MiB;

#define LAS __attribute__((address_space(3)))
constexpr size_t OFF_BAR = 7 * MiB;
constexpr size_t OFF_CEN = OFF_BAR + 16384;
constexpr size_t BAR_MEMSET_BYTES = 16384 + 16384 + 256;

__device__ __forceinline__ int tid_fresh() {
  int t = threadIdx.x;
  asm volatile("" : "+v"(t));
  return t;
}
#define TIDX (tid_fresh() & 255)

__device__ __forceinline__ float bf2f(bf16_t h) { return __uint_as_float(((uint32_t)h) << 16); }
__device__ __forceinline__ float bfs2f(short h) { return __uint_as_float(((uint32_t)(unsigned short)h) << 16); }
typedef __attribute__((ext_vector_type(2))) float cvt_f2_t;
typedef __attribute__((ext_vector_type(2))) __bf16 cvt_bf2_t;
__device__ __forceinline__ uint32_t cvt_pk_bf16(float lo, float hi) {
  const cvt_f2_t v = {lo, hi};
  return __builtin_bit_cast(uint32_t, __builtin_convertvector(v, cvt_bf2_t));
}
__device__ __forceinline__ bf16_t f2bf(float f) { return (bf16_t)(cvt_pk_bf16(f, f) & 0xffffu); }
typedef __attribute__((ext_vector_type(4))) unsigned int u32x4_t;
__device__ __forceinline__ bf16x8 pack8(float a0, float a1, float a2, float a3, float a4, float a5, float a6, float a7) {
  u32x4_t r = {cvt_pk_bf16(a0, a1), cvt_pk_bf16(a2, a3), cvt_pk_bf16(a4, a5), cvt_pk_bf16(a6, a7)};
  return __builtin_bit_cast(bf16x8, r);
}
__device__ __forceinline__ float sigmoidf_(float x) { return __builtin_amdgcn_rcpf(1.f + __expf(-x)); }
__device__ __forceinline__ float siluf_(float x) { return x * __builtin_amdgcn_rcpf(1.f + __expf(-x)); }
__device__ __forceinline__ float softplusf_(float x) { return x > 20.f ? x : log1pf(__expf(x)); }
__device__ __forceinline__ float wave_sum(float v) {
#pragma unroll
  for (int m = 32; m >= 1; m >>= 1) v += __shfl_xor(v, m, 64);
  return v;
}
__device__ __forceinline__ uint2 pack4(float a, float b, float c, float d) {
  uint2 r;
  r.x = cvt_pk_bf16(a, b);
  r.y = cvt_pk_bf16(c, d);
  return r;
}

__device__ __forceinline__ void store16(bf16_t* dst, const f32x4 (&a)[4]) {
  const bf16x8 o0 = pack8(a[0][0], a[0][1], a[0][2], a[0][3], a[1][0], a[1][1], a[1][2], a[1][3]);
  const bf16x8 o1 = pack8(a[2][0], a[2][1], a[2][2], a[2][3], a[3][0], a[3][1], a[3][2], a[3][3]);
  *(bf16x8*)dst = o0;
  *(bf16x8*)(dst + 8) = o1;
}

constexpr int LSTR = 144;
constexpr int SMEM_BYTES = 54272;

template <class AF, class BF, class EF>
__device__ __forceinline__ void gemm_tile(AF af, BF bf, int nk, EF ef, char* smem) {
  const int tid = TIDX, lane = tid & 63, wid = tid >> 6, wr = wid >> 1, wc = wid & 1, fr = lane & 15,
            fq = lane >> 4;
  char* sA = smem;
  char* sB = smem + 128 * LSTR;
  const int lrow = tid >> 3, lkc = tid & 7;
  bf16x8 ra[4], rb[4];
  f32x4 acc[4][4];
#pragma unroll
  for (int m = 0; m < 4; ++m)
#pragma unroll
    for (int n = 0; n < 4; ++n) acc[m][n] = (f32x4){0.f, 0.f, 0.f, 0.f};
#pragma unroll
  for (int i = 0; i < 4; ++i) {
    ra[i] = af(i, lrow + 32 * i, lkc * 8);
    rb[i] = bf(i, lrow + 32 * i, lkc * 8);
  }
  for (int kt = 0; kt < nk; ++kt) {
    __syncthreads();
#pragma unroll
    for (int i = 0; i < 4; ++i) {
      *(bf16x8*)(sA + (lrow + 32 * i) * LSTR + lkc * 16) = ra[i];
      *(bf16x8*)(sB + (lrow + 32 * i) * LSTR + lkc * 16) = rb[i];
    }
    __syncthreads();
    if (kt + 1 < nk) {
#pragma unroll
      for (int i = 0; i < 4; ++i) {
        ra[i] = af(i, lrow + 32 * i, (kt + 1) * 64 + lkc * 8);
        rb[i] = bf(i, lrow + 32 * i, (kt + 1) * 64 + lkc * 8);
      }
    }
#pragma unroll
    for (int s = 0; s < 2; ++s) {
      bf16x8 a[4], b[4];
#pragma unroll
      for (int m = 0; m < 4; ++m) a[m] = *(const bf16x8*)(sA + (wr * 64 + m * 16 + fr) * LSTR + s * 64 + fq * 16);
#pragma unroll
      for (int n = 0; n < 4; ++n) b[n] = *(const bf16x8*)(sB + (wc * 64 + n * 16 + fr) * LSTR + s * 64 + fq * 16);
#pragma unroll
      for (int m = 0; m < 4; ++m)
#pragma unroll
        for (int n = 0; n < 4; ++n) acc[m][n] = __builtin_amdgcn_mfma_f32_16x16x32_bf16(b[n], a[m], acc[m][n], 0, 0, 0);
    }
  }
  ef(acc, wr * 64 + fr, wc * 64 + fq * 16);
}

__device__ __forceinline__ void ph_prep(const P& p, int bid, int nb, char* smem) {
  float* sc = (float*)smem;
  float* red = sc + 4096;
  const int tid = TIDX;
  float* mod = (float*)(p.ws + OFF_MOD);
  for (int i = tid; i < 4096; i += 256) sc[i] = siluf_(p.c[i]);
  __syncthreads();
  for (int u = bid; u < 768; u += nb) {
    const int l = u / 384, e0 = (u % 384) * 16;
    const int kq = tid >> 4, col = tid & 15;
    const int dbase = kq * 64;
    const float* w = p.mod_w + ((size_t)l * 1024 + dbase) * 6144 + e0 + col;
    float a0 = 0, a1 = 0, a2 = 0, a3 = 0;
#pragma unroll 16
    for (int d = 0; d < 64; ++d) {
      float wv = w[(size_t)d * 6144];
      int dd = dbase + d;
      a0 += sc[dd] * wv;
      a1 += sc[1024 + dd] * wv;
      a2 += sc[2048 + dd] * wv;
      a3 += sc[3072 + dd] * wv;
    }
    red[(kq * 16 + col) * 4 + 0] = a0;
    red[(kq * 16 + col) * 4 + 1] = a1;
    red[(kq * 16 + col) * 4 + 2] = a2;
    red[(kq * 16 + col) * 4 + 3] = a3;
    __syncthreads();
    if (tid < 64) {
      int b = tid >> 4, c2 = tid & 15;
      float sm = 0;
      for (int q = 0; q < 16; ++q) sm += red[(q * 16 + c2) * 4 + b];
      mod[(l * 4 + b) * 6144 + e0 + c2] = sm + p.mod_b[l * 6144 + e0 + c2];
    }
    __syncthreads();
  }
  if (bid == 0) {
    float* lb = (float*)(p.ws + OFF_LB);
    for (int ch = tid; ch < 1024; ch += 256) {
      float l0 = p.lb_logits[ch], l1 = p.lb_logits[1024 + ch], l2 = p.lb_logits[2048 + ch];
      float m = fmaxf(l0, fmaxf(l1, l2));
      float e0 = __expf(l0 - m), e1 = __expf(l1 - m), e2 = __expf(l2 - m);
      lb[ch] = e1 / (e0 + e1 + e2);
    }
    int* cnt = (int*)(p.ws + OFF_CNTP);
    if (tid < 48) cnt[(tid / 24) * CNT_LAYER + (tid % 24) * CNT_STRIDE] = 0;
  }
}

template <int MODE>
__device__ __forceinline__ int rowmap(int n) {
  if (MODE == 0) return n;
  if (MODE == 3) return (n & ~63) + ((n >> 2) & 3) * 16 + ((n >> 4) & 3) * 4 + (n & 3);
  return (n >> 4) * 32 + (MODE - 1) * 16 + (n & 15);
}
template <int MODE>
__device__ __forceinline__ void conv_mat(const float* src, int lds_, int K, int N, bf16_t* dst, int ldd, int dk0, const float* scale,
                         int bid, int nb, char* smem, int& woff, int smode = 1) {
  const int t_ = tid_fresh(), lane = t_ & 63, wv = t_ >> 6;
  float* tile = (float*)(smem - ((t_ >> 8) * 65536)) + wv * (64 * 33);
  const int gw = (bid >> 1) * 8 + wv, nw = (nb >> 1) * 8;
  const int tn = N >> 5, ntile = (K >> 6) * tn;
  const int lr = lane >> 3, lc = (lane & 7) * 4;
  const int on = lane & 31, okh = lane >> 5;
  const int first = (gw + nw - (woff % nw)) % nw;
  woff += ntile;
  for (int t = first; t < ntile; t += nw) {
    const int k0 = (t / tn) * 64, n0 = (t % tn) * 32;
    float4 v[8];
#pragma unroll
    for (int i = 0; i < 8; ++i) v[i] = *(const float4*)(src + (size_t)(k0 + lr + 8 * i) * lds_ + n0 + lc);
#pragma unroll
    for (int i = 0; i < 8; ++i) {
      const int r = lr + 8 * i;
      float sc = 1.f;
      if (scale) sc = (smode == 1 ? scale[k0 + r] : 1.f - scale[k0 + r]);
      float* d = tile + r * 33 + lc;
      d[0] = v[i].x * sc;
      d[1] = v[i].y * sc;
      d[2] = v[i].z * sc;
      d[3] = v[i].w * sc;
    }
    __builtin_amdgcn_wave_barrier();
    bf16_t* drow = dst + (size_t)rowmap<MODE>(n0 + on) * ldd + dk0 + k0;
#pragma unroll
    for (int q = 0; q < 4; ++q) {
      const int kc = okh + 2 * q;
      const float* tq = tile + kc * 8 * 33 + on;
      const bf16x8 o = pack8(tq[0], tq[33], tq[66], tq[99], tq[132], tq[165], tq[198], tq[231]);
      *(bf16x8*)(drow + kc * 8) = o;
    }
    __builtin_amdgcn_wave_barrier();
  }
}
__device__ __forceinline__ void ph_conv_w0(const P& p, int bid, int nb, char* smem) {
  int woff = 0;
  conv_mat<0>(p.w_in, 6672, 1024, NPROJ, (bf16_t*)(p.ws + OFF_WINT), 1024, 0, nullptr, bid, nb, smem, woff);
  conv_mat<0>(p.w_out, 1024, 2048, 1024, (bf16_t*)(p.ws + OFF_WOUTT), 2048, 0, nullptr, bid, nb, smem, woff);
}
__device__ __forceinline__ void ph_conv_w1(const P& p, int bid, int nb, char* smem) {
  int woff = 1000;
  for (int i = 0; i < 3; ++i)
    conv_mat<0>(p.w_rkv + (size_t)i * 1048576, 1024, 1024, 1024, (bf16_t*)(p.ws + OFF_WRKVT) + (size_t)i * 1048576,
                1024, 0, nullptr, bid, nb, smem, woff);
  conv_mat<0>(p.w_o, 1024, 1024, 1024, (bf16_t*)(p.ws + OFF_WOT), 1024, 0, nullptr, bid, nb, smem, woff);
  bf16_t* l1 = (bf16_t*)(p.ws + OFF_LORA1T);
  conv_mat<3>(p.dec1, 64, 1024, 64, l1, 2048, 0, p.mu + 3 * 1024, bid, nb, smem, woff, 2);
  conv_mat<3>(p.dec1, 64, 1024, 64, l1, 2048, 1024, p.mu + 3 * 1024, bid, nb, smem, woff);
  conv_mat<3>(p.a1, 64, 1024, 64, l1 + 64 * 2048, 2048, 0, p.mu + 4 * 1024, bid, nb, smem, woff, 2);
  conv_mat<3>(p.a1, 64, 1024, 64, l1 + 64 * 2048, 2048, 1024, p.mu + 4 * 1024, bid, nb, smem, woff);
  conv_mat<3>(p.g1, 128, 1024, 128, l1 + 128 * 2048, 2048, 0, p.mu + 5 * 1024, bid, nb, smem, woff, 2);
  conv_mat<3>(p.g1, 128, 1024, 128, l1 + 128 * 2048, 2048, 1024, p.mu + 5 * 1024, bid, nb, smem, woff);
  conv_mat<3>(p.dec2, 1024, 64, 1024, (bf16_t*)(p.ws + OFF_DEC2T), 64, 0, nullptr, bid, nb, smem, woff);
  conv_mat<3>(p.a2, 1024, 64, 1024, (bf16_t*)(p.ws + OFF_A2T), 64, 0, nullptr, bid, nb, smem, woff);
  conv_mat<3>(p.g2, 1024, 128, 1024, (bf16_t*)(p.ws + OFF_G2T), 128, 0, nullptr, bid, nb, smem, woff);
}
__device__ __forceinline__ void ph_conv_moe(const P& p, int layer, int bid, int nb, char* smem) {
  int woff = 0;
  for (int e = 0; e < 16; ++e) {
    size_t so = ((size_t)layer * 16 + e) * 524288;
    bf16_t* d13 = (bf16_t*)(p.ws + OFF_W13T) + (size_t)e * 1048576;
    conv_mat<1>(p.moe_w1 + so, 512, 1024, 512, d13, 1024, 0, nullptr, bid, nb, smem, woff);
    conv_mat<2>(p.moe_w3 + so, 512, 1024, 512, d13, 1024, 0, nullptr, bid, nb, smem, woff);
    conv_mat<0>(p.moe_w2 + so, 1024, 512, 1024, (bf16_t*)(p.ws + OFF_W2T) + (size_t)e * 524288, 512, 0, nullptr, bid, nb, smem, woff);
  }
}

__device__ __forceinline__ void row_norm_mod(const float* xrow, const float* nw, const float* sh, const float* sc,
                                             int lane, float (&h)[16]) {
  const float4* xr = (const float4*)xrow;
  float4 v[4];
  float ss = 0;
#pragma unroll
  for (int i = 0; i < 4; ++i) {
    v[i] = xr[lane + 64 * i];
    ss += v[i].x * v[i].x + v[i].y * v[i].y + v[i].z * v[i].z + v[i].w * v[i].w;
  }
  ss = wave_sum(ss);
  float rstd = rsqrtf(ss * (1.f / 1024.f) + 1e-6f);
#pragma unroll
  for (int i = 0; i < 4; ++i) {
    int d0 = (lane + 64 * i) * 4;
    float4 w4 = *(const float4*)(nw + d0), s4 = *(const float4*)(sh + d0), c4 = *(const float4*)(sc + d0);
    h[i * 4 + 0] = v[i].x * rstd * w4.x * (1.f + c4.x) + s4.x;
    h[i * 4 + 1] = v[i].y * rstd * w4.y * (1.f + c4.y) + s4.y;
    h[i * 4 + 2] = v[i].z * rstd * w4.z * (1.f + c4.z) + s4.z;
    h[i * 4 + 3] = v[i].w * rstd * w4.w * (1.f + c4.w) + s4.w;
  }
}
__device__ __forceinline__ void store_hbf(bf16_t* hrow, int lane, const float (&h)[16]) {
#pragma unroll
  for (int i = 0; i < 4; ++i) {
    int d0 = (lane + 64 * i) * 4;
    *(uint2*)(hrow + d0) = pack4(h[i * 4], h[i * 4 + 1], h[i * 4 + 2], h[i * 4 + 3]);
  }
}

template <int CTRL>
__device__ __forceinline__ float dpp_mov(float x) {
  return __int_as_float(__builtin_amdgcn_update_dpp(0, __float_as_int(x), CTRL, 0xf, 0xf, true));
}
__device__ __forceinline__ float row16_sum(float x) {
  x += dpp_mov<0xB1>(x);
  x += dpp_mov<0x4E>(x);
  x += dpp_mov<0x141>(x);
  x += dpp_mov<0x140>(x);
  return x;
}

__device__ __forceinline__ void tok_fill_tables(float* tb, const float* nw, const float* sh0, const float* sc0,
                                                const float* wsrc, int wstride) {
  const int t = tid_fresh();
  __syncthreads();
  for (int i = t; i < 4096; i += 512) {
    const int b = i >> 10, d = i & 1023;
    tb[i] = nw[d] * (1.f + sc0[b * 6144 + d]);
    tb[4096 + i] = sh0[b * 6144 + d];
  }
  if (wsrc) {
    for (int i = t; i < 4096; i += 512) {
      const int d = i >> 2, q = i & 3;
      const int ln = (d >> 2) & 63, ii = d >> 8, jj = d & 3;
      const float4 w4 = *(const float4*)(wsrc + (size_t)d * wstride + q * 4);
      *(float4*)(tb + 8192 + ((q * 1024) + (ii * 4 + jj) * 64 + ln) * 4) = w4;
    }
  }
  __syncthreads();
}
__device__ __forceinline__ float xpose_reduce16(const float (&v)[16], int lane) {
  const bool s3 = (lane & 8) != 0, s2 = (lane & 4) != 0, s1 = (lane & 2) != 0, s0 = (lane & 1) != 0;
  float a[8];
#pragma unroll
  for (int j = 0; j < 8; ++j) a[j] = (s3 ? v[8 + j] : v[j]) + dpp_mov<0x140>(s3 ? v[j] : v[8 + j]);
  float b[4];
#pragma unroll
  for (int j = 0; j < 4; ++j) b[j] = (s2 ? a[4 + j] : a[j]) + dpp_mov<0x141>(s2 ? a[j] : a[4 + j]);
  float c[2];
#pragma unroll
  for (int j = 0; j < 2; ++j) c[j] = (s1 ? b[2 + j] : b[j]) + dpp_mov<0x4E>(s1 ? b[j] : b[2 + j]);
  float d = (s0 ? c[1] : c[0]) + dpp_mov<0xB1>(s0 ? c[0] : c[1]);
  d += __shfl_xor(d, 16, 64);
  d += __shfl_xor(d, 32, 64);
  return d;
}
__device__ __forceinline__ void rows2_load(const float* x0, const float* x1, int lane, float4 (&v0)[4], float4 (&v1)[4]) {
#pragma unroll
  for (int i = 0; i < 4; ++i) {
    v0[i] = ((const float4*)x0)[lane + 64 * i];
    v1[i] = ((const float4*)x1)[lane + 64 * i];
  }
}
__device__ __forceinline__ void norm2_calc(const float4 (&v0)[4], const float4 (&v1)[4], const float* tb, int b, int lane,
                                           float (&h0)[16], float (&h1)[16]) {
  float ss0 = 0.f, ss1 = 0.f;
#pragma unroll
  for (int i = 0; i < 4; ++i) {
    ss0 += v0[i].x * v0[i].x + v0[i].y * v0[i].y + v0[i].z * v0[i].z + v0[i].w * v0[i].w;
    ss1 += v1[i].x * v1[i].x + v1[i].y * v1[i].y + v1[i].z * v1[i].z + v1[i].w * v1[i].w;
  }
#pragma unroll
  for (int m = 32; m >= 1; m >>= 1) {
    ss0 += __shfl_xor(ss0, m, 64);
    ss1 += __shfl_xor(ss1, m, 64);
  }
  const float r0 = rsqrtf(ss0 * (1.f / 1024.f) + 1e-6f), r1 = rsqrtf(ss1 * (1.f / 1024.f) + 1e-6f);
#pragma unroll
  for (int i = 0; i < 4; ++i) {
    const float4 sc = *(const float4*)(tb + b * 1024 + (lane + 64 * i) * 4);
    const float4 sh = *(const float4*)(tb + 4096 + b * 1024 + (lane + 64 * i) * 4);
    h0[i * 4 + 0] = v0[i].x * r0 * sc.x + sh.x;
    h0[i * 4 + 1] = v0[i].y * r0 * sc.y + sh.y;
    h0[i * 4 + 2] = v0[i].z * r0 * sc.z + sh.z;
    h0[i * 4 + 3] = v0[i].w * r0 * sc.w + sh.w;
    h1[i * 4 + 0] = v1[i].x * r1 * sc.x + sh.x;
    h1[i * 4 + 1] = v1[i].y * r1 * sc.y + sh.y;
    h1[i * 4 + 2] = v1[i].z * r1 * sc.z + sh.z;
    h1[i * 4 + 3] = v1[i].w * r1 * sc.w + sh.w;
  }
}
__device__ __forceinline__ void norm2(const float* x0, const float* x1, const float* tb, int b, int lane, float (&h0)[16],
                                      float (&h1)[16]) {
  float4 v0[4], v1[4];
  rows2_load(x0, x1, lane, v0, v1);
  norm2_calc(v0, v1, tb, b, lane, h0, h1);
}
__device__ __forceinline__ void dots2(const float* tb, int lane, const float (&h0)[16], const float (&h1)[16],
                                      float (&a0)[16], float (&a1)[16]) {
#pragma unroll
  for (int j = 0; j < 16; ++j) a0[j] = a1[j] = 0.f;
#pragma unroll
  for (int ij = 0; ij < 16; ++ij) {
#pragma unroll
    for (int q = 0; q < 4; ++q) {
      const float4 w4 = *(const float4*)(tb + 8192 + (q * 1024 + ij * 64 + lane) * 4);
      a0[q * 4 + 0] += h0[ij] * w4.x;
      a0[q * 4 + 1] += h0[ij] * w4.y;
      a0[q * 4 + 2] += h0[ij] * w4.z;
      a0[q * 4 + 3] += h0[ij] * w4.w;
      a1[q * 4 + 0] += h1[ij] * w4.x;
      a1[q * 4 + 1] += h1[ij] * w4.y;
      a1[q * 4 + 2] += h1[ij] * w4.z;
      a1[q * 4 + 3] += h1[ij] * w4.w;
    }
    if ((ij & 1) == 1) asm volatile("" ::: "memory");
  }
}

__device__ __forceinline__ void ph_norm0(const P& p, int bid, int nb, char* smem) {
  float* tb = (float*)(smem - ((tid_fresh() >> 8) * 65536));
  const float* mod = (const float*)(p.ws + OFF_MOD);
  tok_fill_tables(tb, p.norm_w, mod, mod + 1024, p.w_in + NPROJ, 6672);
  const int tf = tid_fresh(), lane = tf & 63, gw = (bid >> 1) * 8 + (tf >> 6), nw = (nb >> 1) * 8;
  bf16_t* hbf = (bf16_t*)(p.ws + OFF_S1);
  float* dt = (float*)(p.ws + OFF_DT);
  for (int ch = gw; ch < T / 8; ch += nw) {
    const int t0 = ch * 8, b = t0 >> 12;
    float4 va0[4], va1[4];
    rows2_load(p.x + (size_t)t0 * 1024, p.x + (size_t)(t0 + 1) * 1024, lane, va0, va1);
#pragma unroll 1
    for (int tt = 0; tt < 8; tt += 2) {
      const int t = t0 + tt;
      float4 vb0[4], vb1[4];
      const int tn = (tt + 2 < 8) ? t + 2 : t;
      rows2_load(p.x + (size_t)tn * 1024, p.x + (size_t)(tn + 1) * 1024, lane, vb0, vb1);
      float h0[16], h1[16], a0[16], a1[16];
      norm2_calc(va0, va1, tb, b, lane, h0, h1);
#pragma unroll
      for (int i = 0; i < 4; ++i) {
        va0[i] = vb0[i];
        va1[i] = vb1[i];
      }
      store_hbf(hbf + (size_t)t * 1024, lane, h0);
      store_hbf(hbf + (size_t)(t + 1) * 1024, lane, h1);
      dots2(tb, lane, h0, h1, a0, a1);
      const float d0 = xpose_reduce16(a0, lane), d1 = xpose_reduce16(a1, lane);
      if (lane < 16) {
        const float bias = p.dt_bias[lane];
        dt[(size_t)t * 16 + lane] = softplusf_(d0 + bias);
        dt[(size_t)(t + 1) * 16 + lane] = softplusf_(d1 + bias);
      }
    }
  }
}

__device__ __forceinline__ void ph_gemm_inproj(const P& p, int bid, int nb, char* smem) {
  const bf16_t* A = (const bf16_t*)(p.ws + OFF_S1);
  const bf16_t* B = (const bf16_t*)(p.ws + OFF_WINT);
  bf16_t* C = (bf16_t*)(p.ws + OFF_PROJ);
  const int MT = 128, NT = 52;
  for (int w = bid; w < MT * NT; w += nb) {
    int mt = w % MT, nt = w / MT;
    const bf16_t* Ab = A + (size_t)mt * 128 * 1024;
    const bf16_t* Bb = B + (size_t)nt * 128 * 1024;
    bf16_t* Cb = C + (size_t)mt * 128 * NPROJ + nt * 128;
    gemm_tile([&](int i, int r, int k) { return *(const bf16x8*)(Ab + (size_t)r * 1024 + k); },
              [&](int i, int r, int k) { return *(const bf16x8*)(Bb + (size_t)r * 1024 + k); }, 16,
              [&](f32x4(&acc)[4][4], int r0, int c0) {
#pragma unroll
                for (int m = 0; m < 4; ++m) store16(Cb + (size_t)(r0 + m * 16) * NPROJ + c0, acc[m]);
              },
              smem);
  }
}

template <bool FIRST>
__device__ __forceinline__ void ph_gemm_resid(const P& p, const bf16_t* A, int lda, const bf16_t* B, int K, const float* gate,
                              int bid, int nb, char* smem) {
  for (int w = bid; w < 128 * 8; w += nb) {
    int mt = w % 128, nt = w / 128;
    const bf16_t* Ab = A + (size_t)mt * 128 * lda;
    const bf16_t* Bb = B + (size_t)nt * 128 * K;
    const float* gt = gate + (size_t)(mt >> 5) * 6144 + nt * 128;
    gemm_tile([&](int i, int r, int k) { return *(const bf16x8*)(Ab + (size_t)r * lda + (FIRST ? (k < 1024 ? k : k + 3072) : k)); },
              [&](int i, int r, int k) { return *(const bf16x8*)(Bb + (size_t)r * K + k); }, K / 64,
              [&](f32x4(&acc)[4][4], int r0, int c0) {
#pragma unroll
                for (int m = 0; m < 4; ++m)
#pragma unroll
                  for (int n = 0; n < 4; ++n) {
                    size_t idx = (size_t)(mt * 128 + r0 + m * 16) * 1024 + nt * 128 + c0 + n * 4;
                    float4 base = FIRST ? *(const float4*)(p.x + idx) : *(const float4*)(p.out + idx);
                    float4 g4 = *(const float4*)(gt + c0 + n * 4);
                    base.x += g4.x * acc[m][n][0];
                    base.y += g4.y * acc[m][n][1];
                    base.z += g4.z * acc[m][n][2];
                    base.w += g4.w * acc[m][n][3];
                    *(float4*)(p.out + idx) = base;
                  }
              },
              smem);
  }
}

__device__ __forceinline__ void ph_conv(const P& p, int bid, int nb) {
  const bf16_t* proj = (const bf16_t*)(p.ws + OFF_PROJ);
  bf16_t* xc = (bf16_t*)p.out;
  for (int idx = bid * 256 + TIDX; idx < T * 192; idx += nb * 256) {
    int t = idx / 192, c0 = (idx % 192) * 8, tl = t & (SEQ - 1);
    float acc[8];
#pragma unroll
    for (int j = 0; j < 8; ++j) acc[j] = p.conv_b[c0 + j];
#pragma unroll
    for (int jj = 0; jj < 4; ++jj) {
      if (tl - 3 + jj >= 0) {
        bf16x8 v = *(const bf16x8*)(proj + (size_t)(t - 3 + jj) * NPROJ + 5120 + c0);
#pragma unroll
        for (int j = 0; j < 8; ++j) acc[j] += p.conv_w[jj * 1536 + c0 + j] * bfs2f(v[j]);
      }
    }
    bf16x8 o;
#pragma unroll
    for (int j = 0; j < 8; ++j) o[j] = (short)f2bf(siluf_(acc[j]));
    *(bf16x8*)(xc + (size_t)t * 1536 + c0) = o;
  }
}

constexpr int LD128 = 136;
constexpr int LD64 = 72;
constexpr size_t OFF_HS = OFF_S2;
constexpr size_t OFF_HB = 4 * MiB;
constexpr size_t OFF_SD = 5 * MiB;
__device__ __forceinline__ bf16_t* ssd_state_ptr(const P& p, int item) {
  return (bf16_t*)(item < 384 ? p.ws + 12 * MiB + (size_t)item * 131072
                              : (char*)p.out + 48 * MiB + (size_t)(item - 384) * 131072);
}
__device__ __forceinline__ f32x4 mfma16(bf16x8 a, bf16x8 b, f32x4 c) {
  return __builtin_amdgcn_mfma_f32_16x16x32_bf16(a, b, c, 0, 0, 0);
}
__device__ __forceinline__ uint32_t pack2(float a, float b) { return cvt_pk_bf16(a, b); }

__device__ __forceinline__ void load_col32(const bf16_t* col, uint32_t (&pk)[16]) {
#pragma unroll
  for (int i = 0; i < 16; ++i)
    pk[i] = (uint32_t)col[(size_t)(2 * i) * NPROJ] | ((uint32_t)col[(size_t)(2 * i + 1) * NPROJ] << 16);
}
__device__ __forceinline__ void hg_front(const uint32_t (&pf)[16], float lbk, int k, int half,
                                         float* tot, float (&fv)[32], float (&bv)[32]) {
  float run = 0.f;
#pragma unroll
  for (int i = 0; i < 32; ++i) {
    const float fr = __uint_as_float((i & 1) ? (pf[i >> 1] & 0xffff0000u) : (pf[i >> 1] << 16));
    float f = lbk + (1.f - lbk) * sigmoidf_(fr);
    fv[i] = f;
    run += __logf(f);
    bv[i] = run;
  }
  if (half == 0) tot[k] = run;
  __syncthreads();
  if (half == 1) {
    float t0 = tot[k];
#pragma unroll
    for (int i = 0; i < 32; ++i) bv[i] += t0;
  }
}

__device__ __forceinline__ void load_col32_raw(const bf16_t* col, uint32_t (&lo)[16], uint32_t (&hi)[16]) {
#pragma unroll
  for (int i = 0; i < 16; ++i) {
    lo[i] = (uint32_t)col[(size_t)(2 * i) * NPROJ];
    hi[i] = (uint32_t)col[(size_t)(2 * i + 1) * NPROJ];
  }
}
__device__ __forceinline__ void hg_phaseA(const P& p, int item, char* smem, uint32_t (&pf)[16], uint32_t (&pv)[16], int nitem) {
  const int tid = TIDX, lane = tid & 63, w = tid >> 6, fr = lane & 15, fq = lane >> 4;
  const int b = item >> 9, h = (item >> 6) & 7, c = item & 63;
  const int k = tid & 127, half = tid >> 7;
  const bf16_t* proj = (const bf16_t*)(p.ws + OFF_PROJ);
  const float* lb = (const float*)(p.ws + OFF_LB);
  bf16_t* KT = (bf16_t*)smem;
  bf16_t* VT = (bf16_t*)(smem + 18432);
  float* tot = (float*)(smem + 36864);
  float* blast = tot + 128;
  const size_t trow = (size_t)b * SEQ + c * 64 + 32 * half;
  __syncthreads();
  uint32_t nfl[16], nfh[16], nvl[16], nvh[16];
  {
    const int ni = nitem >= 0 ? nitem : item;
    const size_t ntrow = (size_t)(ni >> 9) * SEQ + (ni & 63) * 64 + 32 * half;
    const int nh = (ni >> 6) & 7;
    load_col32_raw(proj + ntrow * NPROJ + 1024 + nh * 128 + k, nfl, nfh);
    load_col32_raw(proj + ntrow * NPROJ + 2048 + nh * 128 + k, nvl, nvh);
  }
  float fv[32], bv[32];
  hg_front(pf, lb[h * 128 + k], k, half, tot, fv, bv);
  if (half == 1) blast[k] = bv[31];
  __syncthreads();
  {
    const float bl = blast[k];
    uint32_t pk[16];
#pragma unroll
    for (int i = 0; i < 16; ++i) {
      float k0 = (1.f - fv[2 * i]) * __expf(bl - bv[2 * i]);
      float k1 = (1.f - fv[2 * i + 1]) * __expf(bl - bv[2 * i + 1]);
      pk[i] = pack2(k0, k1);
    }
    uint4* kd = (uint4*)(KT + k * LD64 + 32 * half);
    uint4* vd = (uint4*)(VT + k * LD64 + 32 * half);
#pragma unroll
    for (int i = 0; i < 4; ++i) {
      kd[i] = make_uint4(pk[4 * i], pk[4 * i + 1], pk[4 * i + 2], pk[4 * i + 3]);
      vd[i] = make_uint4(pv[4 * i], pv[4 * i + 1], pv[4 * i + 2], pv[4 * i + 3]);
    }
    if (half == 1) ((float*)(p.ws + OFF_HB))[(size_t)item * 128 + k] = bl;
  }
  __syncthreads();
  f32x4 acc[2][8];
#pragma unroll
  for (int a = 0; a < 2; ++a)
#pragma unroll
    for (int vt = 0; vt < 8; ++vt) acc[a][vt] = (f32x4){0.f, 0.f, 0.f, 0.f};
#pragma unroll
  for (int ks = 0; ks < 2; ++ks) {
    bf16x8 kf[2];
#pragma unroll
    for (int a = 0; a < 2; ++a) kf[a] = *(const bf16x8*)(KT + ((2 * w + a) * 16 + fr) * LD64 + ks * 32 + fq * 8);
#pragma unroll
    for (int vt = 0; vt < 8; ++vt) {
      bf16x8 vf = *(const bf16x8*)(VT + (vt * 16 + fr) * LD64 + ks * 32 + fq * 8);
#pragma unroll
      for (int a = 0; a < 2; ++a) acc[a][vt] = mfma16(kf[a], vf, acc[a][vt]);
    }
  }
  bf16_t* hs = (bf16_t*)(p.ws + OFF_HS) + (size_t)item * 16384;
#pragma unroll
  for (int a = 0; a < 2; ++a)
#pragma unroll
    for (int vt = 0; vt < 8; ++vt)
      *(uint2*)(hs + (vt * 16 + fr) * 128 + (2 * w + a) * 16 + fq * 4) =
          pack4(acc[a][vt][0], acc[a][vt][1], acc[a][vt][2], acc[a][vt][3]);
  __builtin_amdgcn_sched_barrier(0);
#pragma unroll
  for (int i = 0; i < 16; ++i) {
    pf[i] = nfl[i] | (nfh[i] << 16);
    pv[i] = nvl[i] | (nvh[i] << 16);
  }
}

__device__ __forceinline__ void hg_phaseB(const P& p, int item, char* smem, int dry) {
  const int tid = TIDX, lane = tid & 63, w = tid >> 6, fr = lane & 15, fq = lane >> 4;
  const int b = item >> 9, h = (item >> 6) & 7, c = item & 63;
  const int k = tid & 127, half = tid >> 7;
  bf16_t* proj = (bf16_t*)(p.ws + OFF_PROJ);
  const float* lb = (const float*)(p.ws + OFF_LB);
  bf16_t* QA = (bf16_t*)smem;
  bf16_t* KM = (bf16_t*)(smem + 17408);
  bf16_t* QM = (bf16_t*)(smem + 34816);
  bf16_t* KA = (bf16_t*)(smem + 43520);
  float* tot = (float*)(smem + 52224);
  float* red = tot + 256;
  bf16_t* VT = (bf16_t*)smem;
  bf16_t* SC = (bf16_t*)(smem + 18432);
  const size_t trow0 = (size_t)b * SEQ + c * 64;
  const size_t trow = trow0 + 32 * half;
  __syncthreads();
  uint32_t pf[16], pq[16], pv[16];
  load_col32(proj + trow * NPROJ + 1024 + h * 128 + k, pf);
  load_col32(proj + trow * NPROJ + h * 128 + k, pq);
  load_col32(proj + trow * NPROJ + 2048 + h * 128 + k, pv);
  const bf16_t* hs = (const bf16_t*)(p.ws + OFF_HS) + (size_t)item * 16384;
  bf16x8 sfr[4][2];
#pragma unroll
  for (int ks = 0; ks < 4; ++ks)
#pragma unroll
    for (int a = 0; a < 2; ++a) sfr[ks][a] = *(const bf16x8*)(hs + ((2 * w + a) * 16 + fr) * 128 + ks * 32 + fq * 8);
  float fv[32], bv[32];
  hg_front(pf, lb[h * 128 + k], k, half, tot, fv, bv);
  {
    const float bmid = tot[k];
#pragma unroll
    for (int i = 0; i < 32; ++i) {
      const float q = __uint_as_float((i & 1) ? (pq[i >> 1] & 0xffff0000u) : (pq[i >> 1] << 16));
      const float kk = 1.f - fv[i];
      const int t = 32 * half + i;
      QA[t * LD128 + k] = f2bf(q * __expf(bv[i]));
      KM[t * LD128 + k] = f2bf(kk * __expf(bmid - bv[i]));
      if (half == 1) QM[i * LD128 + k] = f2bf(q * __expf(bv[i] - bmid));
      else KA[i * LD128 + k] = f2bf(kk * __expf(-bv[i]));
    }
  }
  __syncthreads();
  f32x4 acc[2][4];
#pragma unroll
  for (int a = 0; a < 2; ++a)
#pragma unroll
    for (int tt = 0; tt < 4; ++tt) acc[a][tt] = (f32x4){0.f, 0.f, 0.f, 0.f};
#pragma unroll
  for (int ks = 0; ks < 4; ++ks) {
#pragma unroll
    for (int tt = 0; tt < 4; ++tt) {
      bf16x8 qf = *(const bf16x8*)(QA + (tt * 16 + fr) * LD128 + ks * 32 + fq * 8);
#pragma unroll
      for (int a = 0; a < 2; ++a) acc[a][tt] = mfma16(sfr[ks][a], qf, acc[a][tt]);
    }
  }
  f32x4 sc2[2], sc1;
  sc2[0] = sc2[1] = sc1 = (f32x4){0.f, 0.f, 0.f, 0.f};
#pragma unroll
  for (int ks = 0; ks < 4; ++ks) {
    bf16x8 kf = *(const bf16x8*)(KM + (16 * w + fr) * LD128 + ks * 32 + fq * 8);
#pragma unroll
    for (int t2 = 0; t2 < 2; ++t2) {
      bf16x8 qf = *(const bf16x8*)(QM + (16 * t2 + fr) * LD128 + ks * 32 + fq * 8);
      sc2[t2] = mfma16(kf, qf, sc2[t2]);
    }
    bf16x8 kaf = *(const bf16x8*)(KA + (16 * (w & 1) + fr) * LD128 + ks * 32 + fq * 8);
    bf16x8 qaf = *(const bf16x8*)(QA + (16 * (w >> 1) + fr) * LD128 + ks * 32 + fq * 8);
    sc1 = mfma16(kaf, qaf, sc1);
  }
  __syncthreads();
  {
#pragma unroll
    for (int t2 = 0; t2 < 2; ++t2) {
      const int t = 32 + 16 * t2 + fr, s0 = 16 * w + fq * 4;
      float v0 = (s0 + 0 <= t) ? sc2[t2][0] : 0.f, v1 = (s0 + 1 <= t) ? sc2[t2][1] : 0.f,
            v2 = (s0 + 2 <= t) ? sc2[t2][2] : 0.f, v3 = (s0 + 3 <= t) ? sc2[t2][3] : 0.f;
      *(uint2*)(SC + t * LD64 + s0) = pack4(v0, v1, v2, v3);
    }
    {
      const int t = 16 * (w >> 1) + fr, s0 = 16 * (w & 1) + fq * 4;
      float v0 = (s0 + 0 <= t) ? sc1[0] : 0.f, v1 = (s0 + 1 <= t) ? sc1[1] : 0.f, v2 = (s0 + 2 <= t) ? sc1[2] : 0.f,
            v3 = (s0 + 3 <= t) ? sc1[3] : 0.f;
      *(uint2*)(SC + t * LD64 + s0) = pack4(v0, v1, v2, v3);
    }
    *(uint2*)(SC + (tid >> 3) * LD64 + 32 + (tid & 7) * 4) = make_uint2(0u, 0u);
    uint4* vd = (uint4*)(VT + k * LD64 + 32 * half);
#pragma unroll
    for (int i = 0; i < 4; ++i) vd[i] = make_uint4(pv[4 * i], pv[4 * i + 1], pv[4 * i + 2], pv[4 * i + 3]);
  }
  __syncthreads();
#pragma unroll
  for (int ks = 0; ks < 2; ++ks) {
    bf16x8 vf[2];
#pragma unroll
    for (int a = 0; a < 2; ++a) vf[a] = *(const bf16x8*)(VT + ((2 * w + a) * 16 + fr) * LD64 + ks * 32 + fq * 8);
#pragma unroll
    for (int tt = 0; tt < 4; ++tt) {
      bf16x8 sf = *(const bf16x8*)(SC + (tt * 16 + fr) * LD64 + ks * 32 + fq * 8);
#pragma unroll
      for (int a = 0; a < 2; ++a) acc[a][tt] = mfma16(vf[a], sf, acc[a][tt]);
    }
  }
#pragma unroll
  for (int tt = 0; tt < 4; ++tt) {
    float ss = 0.f;
#pragma unroll
    for (int a = 0; a < 2; ++a)
#pragma unroll
      for (int j = 0; j < 4; ++j) ss += acc[a][tt][j] * acc[a][tt][j];
    ss += __shfl_xor(ss, 16, 64);
    ss += __shfl_xor(ss, 32, 64);
    if (fq == 0) red[w * 64 + tt * 16 + fr] = ss;
  }
  __syncthreads();
#pragma unroll
  for (int tt = 0; tt < 4; ++tt) {
    const int t = tt * 16 + fr;
    const float ss = red[t] + red[64 + t] + red[128 + t] + red[192 + t];
    const float rstd = rsqrtf(ss * (1.f / 128.f) + 1e-6f);
    bf16_t* orow = proj + (trow0 + t) * NPROJ + h * 128;
#pragma unroll
    for (int a = 0; a < 2; ++a) {
      const int v0 = (2 * w + a) * 16 + fq * 4;
      const bf16x4 g4 = *(const bf16x4*)(orow + 3072 + v0);
      const float4 n4 = *(const float4*)(p.hg_norm + h * 128 + v0);
      if (!dry) *(uint2*)(orow + v0) = pack4(acc[a][tt][0] * rstd * n4.x * siluf_(bfs2f(g4[0])),
                                   acc[a][tt][1] * rstd * n4.y * siluf_(bfs2f(g4[1])),
                                   acc[a][tt][2] * rstd * n4.z * siluf_(bfs2f(g4[2])),
                                   acc[a][tt][3] * rstd * n4.w * siluf_(bfs2f(g4[3])));
    }
  }
}

__device__ __forceinline__ void ssd_acs(const P& p, size_t trow0, int g, float* acs, float* dts) {
  const int lane = TIDX & 63;
  if (TIDX < 64) {
    const float* dt = (const float*)(p.ws + OFF_DT) + (trow0 + lane) * 16 + g * 8;
#pragma unroll
    for (int j = 0; j < 8; ++j) {
      float d = dt[j];
      float v = d * (-__expf(p.a_log[g * 8 + j]));
#pragma unroll
      for (int off = 1; off < 64; off <<= 1) {
        float u = __shfl_up(v, off, 64);
        if (lane >= off) v += u;
      }
      acs[lane * 8 + j] = v;
      dts[lane * 8 + j] = d;
    }
  }
}

__device__ __forceinline__ void ssd_phaseA(const P& p, int item, char* smem) {
  const int tid = TIDX, lane = tid & 63, w = tid >> 6, fr = lane & 15, fq = lane >> 4;
  const int b = item >> 7, g = (item >> 6) & 1, c = item & 63;
  const bf16_t* xc = (const bf16_t*)p.out;
  bf16_t* BT = (bf16_t*)smem;
  bf16_t* XT = (bf16_t*)(smem + 18432);
  float* acs = (float*)(smem + 36864);
  float* dts = acs + 512;
  const size_t trow0 = (size_t)b * SEQ + c * 64;
  __syncthreads();
  if (tid < 192) {
    const int q = tid % 96, hf = tid / 96;
    const int col = q < 64 ? g * 512 + q * 8 : (q < 80 ? 1024 + g * 128 + (q - 64) * 8 : 1280 + g * 128 + (q - 80) * 8);
    const bf16_t* proj_ = (const bf16_t*)(p.ws + OFF_PROJ);
    bf16_t* xw = (bf16_t*)p.out;
    float wc[4][8], bc[8];
#pragma unroll
    for (int j = 0; j < 8; ++j) {
      bc[j] = p.conv_b[col + j];
#pragma unroll
      for (int jj = 0; jj < 4; ++jj) wc[jj][j] = p.conv_w[jj * 1536 + col + j];
    }
    const int ts = c * 64 + hf * 32;
    float x0[8], x1[8], x2[8];
#pragma unroll
    for (int j = 0; j < 8; ++j) x0[j] = x1[j] = x2[j] = 0.f;
    if (ts >= 3) {
      const bf16_t* r0 = proj_ + ((size_t)b * SEQ + ts - 3) * NPROJ + 5120 + col;
      const bf16x8 a = *(const bf16x8*)r0, bb = *(const bf16x8*)(r0 + NPROJ), cc = *(const bf16x8*)(r0 + 2 * NPROJ);
#pragma unroll
      for (int j = 0; j < 8; ++j) {
        x0[j] = bfs2f(a[j]);
        x1[j] = bfs2f(bb[j]);
        x2[j] = bfs2f(cc[j]);
      }
    }
#pragma unroll 1
    for (int i0 = 0; i0 < 32; i0 += 16) {
    bf16x8 rows[16];
#pragma unroll
    for (int i = 0; i < 16; ++i) rows[i] = *(const bf16x8*)(proj_ + ((size_t)b * SEQ + ts + i0 + i) * NPROJ + 5120 + col);
#pragma unroll
    for (int ii = 0; ii < 16; ++ii) {
      const int i = i0 + ii;
      const size_t tr = (size_t)b * SEQ + ts + i;
      const bf16x8 cur = rows[ii];
      bf16x8 o;
#pragma unroll
      for (int j = 0; j < 8; ++j) {
        const float x3 = bfs2f(cur[j]);
        const float acc = bc[j] + wc[0][j] * x0[j] + wc[1][j] * x1[j] + wc[2][j] * x2[j] + wc[3][j] * x3;
        o[j] = (short)f2bf(siluf_(acc));
        x0[j] = x1[j];
        x1[j] = x2[j];
        x2[j] = x3;
      }
      *(bf16x8*)(xw + tr * 1536 + col) = o;
    }
    }
  }
  __threadfence_block();
  __syncthreads();
  ssd_acs(p, trow0, g, acs, dts);
  {
    const int n = tid & 127, half = tid >> 7;
    const bf16_t* brow = xc + (trow0 + 32 * half) * 1536 + 1024 + g * 128 + n;
    uint32_t pb[16];
#pragma unroll
    for (int i = 0; i < 16; ++i)
      pb[i] = (uint32_t)brow[(size_t)(2 * i) * 1536] | ((uint32_t)brow[(size_t)(2 * i + 1) * 1536] << 16);
    uint4* bd = (uint4*)(BT + n * LD64 + 32 * half);
#pragma unroll
    for (int i = 0; i < 4; ++i) bd[i] = make_uint4(pb[4 * i], pb[4 * i + 1], pb[4 * i + 2], pb[4 * i + 3]);
  }
  __syncthreads();
  bf16_t* ss = ssd_state_ptr(p, item);
  if (tid < 8) ((float*)(p.ws + OFF_SD))[item * 8 + tid] = __expf(acs[63 * 8 + tid]);
  const int pp = tid & 63, sq = tid >> 6;
  uint32_t xr[16];
  {
    const bf16_t* xrow = xc + (trow0 + 16 * sq) * 1536 + (g * 8) * 64 + pp;
#pragma unroll
    for (int i = 0; i < 16; ++i) xr[i] = (uint32_t)xrow[(size_t)i * 1536];
  }
#pragma unroll 1
  for (int j = 0; j < 8; ++j) {
    bf16_t* xt = XT + (j & 1) * 64 * LD64;
    {
      const float al = acs[63 * 8 + j];
      uint32_t px[8];
#pragma unroll
      for (int i = 0; i < 8; ++i) {
        const int s0 = 16 * sq + 2 * i;
        float x0 = __uint_as_float(xr[2 * i] << 16) * dts[s0 * 8 + j] * __expf(al - acs[s0 * 8 + j]);
        float x1 = __uint_as_float(xr[2 * i + 1] << 16) * dts[(s0 + 1) * 8 + j] * __expf(al - acs[(s0 + 1) * 8 + j]);
        px[i] = pack2(x0, x1);
      }
      uint4* xd = (uint4*)(xt + pp * LD64 + 16 * sq);
      xd[0] = make_uint4(px[0], px[1], px[2], px[3]);
      xd[1] = make_uint4(px[4], px[5], px[6], px[7]);
    }
    {
      const int jn = j < 7 ? j + 1 : j;
      const bf16_t* xrow = xc + (trow0 + 16 * sq) * 1536 + (g * 8 + jn) * 64 + pp;
#pragma unroll
      for (int i = 0; i < 16; ++i) xr[i] = (uint32_t)xrow[(size_t)i * 1536];
    }
    __syncthreads();
    f32x4 acc[2][4];
#pragma unroll
    for (int a = 0; a < 2; ++a)
#pragma unroll
      for (int pt = 0; pt < 4; ++pt) acc[a][pt] = (f32x4){0.f, 0.f, 0.f, 0.f};
#pragma unroll
    for (int ks = 0; ks < 2; ++ks) {
      bf16x8 bfr[2];
#pragma unroll
      for (int a = 0; a < 2; ++a) bfr[a] = *(const bf16x8*)(BT + ((2 * w + a) * 16 + fr) * LD64 + ks * 32 + fq * 8);
#pragma unroll
      for (int pt = 0; pt < 4; ++pt) {
        bf16x8 xf = *(const bf16x8*)(xt + (pt * 16 + fr) * LD64 + ks * 32 + fq * 8);
#pragma unroll
        for (int a = 0; a < 2; ++a) acc[a][pt] = mfma16(bfr[a], xf, acc[a][pt]);
      }
    }
#pragma unroll
    for (int a = 0; a < 2; ++a)
#pragma unroll
      for (int pt = 0; pt < 4; ++pt)
        *(uint2*)(ss + (size_t)j * 8192 + (pt * 16 + fr) * 128 + (2 * w + a) * 16 + fq * 4) =
            pack4(acc[a][pt][0], acc[a][pt][1], acc[a][pt][2], acc[a][pt][3]);
  }
}

__device__ __forceinline__ void ssd_phaseB(const P& p, int item, char* smem, int dry) {
  const int tid = TIDX, lane = tid & 63, w = tid >> 6, fr = lane & 15, fq = lane >> 4;
  const int b = item >> 7, g = (item >> 6) & 1, c = item & 63;
  const bf16_t* xc = (const bf16_t*)p.out;
  bf16_t* proj = (bf16_t*)(p.ws + OFF_PROJ);
  bf16_t* Cs = (bf16_t*)smem;
  bf16_t* Bs = (bf16_t*)(smem + 17408);
  bf16_t* XT = (bf16_t*)(smem + 17408);
  bf16_t* SCw = (bf16_t*)(smem + 35840) + w * 16 * LD64;
  float* acs = (float*)(smem + 45056);
  float* dts = acs + 512;
  const size_t trow0 = (size_t)b * SEQ + c * 64;
  __syncthreads();
  const bf16_t* ss = ssd_state_ptr(p, item);
  const int l = 16 * w + fr;
  const int pp = tid & 63, sq = tid >> 6;
  uint32_t rl0[8], rh0[8];
  {
    const bf16_t* xrow = xc + (trow0 + 16 * sq) * 1536 + (g * 8) * 64 + pp;
#pragma unroll
    for (int i = 0; i < 8; ++i) {
      rl0[i] = (uint32_t)xrow[(size_t)(2 * i) * 1536];
      rh0[i] = (uint32_t)xrow[(size_t)(2 * i + 1) * 1536];
    }
  }
  bf16x8 sfr[4][4];
#pragma unroll
  for (int ks = 0; ks < 4; ++ks)
#pragma unroll
    for (int pt = 0; pt < 4; ++pt) sfr[ks][pt] = *(const bf16x8*)(ss + (pt * 16 + fr) * 128 + ks * 32 + fq * 8);
  ssd_acs(p, trow0, g, acs, dts);
#pragma unroll
  for (int i = 0; i < 4; ++i) {
    const int idx = tid + i * 256, row = idx >> 4, ch = idx & 15;
    const bf16_t* src = xc + (trow0 + row) * 1536 + g * 128 + ch * 8;
    *(bf16x8*)(Bs + row * LD128 + ch * 8) = *(const bf16x8*)(src + 1024);
    *(bf16x8*)(Cs + row * LD128 + ch * 8) = *(const bf16x8*)(src + 1280);
  }
  __syncthreads();
  bf16x8 cf[4];
  f32x4 cb[4];
#pragma unroll
  for (int st = 0; st < 4; ++st) cb[st] = (f32x4){0.f, 0.f, 0.f, 0.f};
#pragma unroll
  for (int ks = 0; ks < 4; ++ks) {
    cf[ks] = *(const bf16x8*)(Cs + (16 * w + fr) * LD128 + ks * 32 + fq * 8);
#pragma unroll
    for (int st = 0; st < 4; ++st) {
      bf16x8 bfr = *(const bf16x8*)(Bs + (st * 16 + fr) * LD128 + ks * 32 + fq * 8);
      cb[st] = mfma16(bfr, cf[ks], cb[st]);
    }
  }
  __syncthreads();
  float ssq = 0.f;
  uint32_t px[8];
#pragma unroll
  for (int i = 0; i < 8; ++i) px[i] = rl0[i] | (rh0[i] << 16);
#pragma unroll 1
  for (int j = 0; j < 8; ++j) {
    bf16_t* xt = XT + (j & 1) * 64 * LD64;
    {
      uint4* xd = (uint4*)(xt + pp * LD64 + 16 * sq);
      xd[0] = make_uint4(px[0], px[1], px[2], px[3]);
      xd[1] = make_uint4(px[4], px[5], px[6], px[7]);
    }
    const int jn = j < 7 ? j + 1 : j;
    uint32_t rl[8], rh[8];
    {
      const bf16_t* xrow = xc + (trow0 + 16 * sq) * 1536 + (g * 8 + jn) * 64 + pp;
#pragma unroll
      for (int i = 0; i < 8; ++i) {
        rl[i] = (uint32_t)xrow[(size_t)(2 * i) * 1536];
        rh[i] = (uint32_t)xrow[(size_t)(2 * i + 1) * 1536];
      }
    }
    bf16x4 x4[4], z4[4];
#pragma unroll
    for (int pt = 0; pt < 4; ++pt) {
      const int ch = (g * 8 + j) * 64 + pt * 16 + fq * 4;
      x4[pt] = *(const bf16x4*)(xc + (trow0 + l) * 1536 + ch);
      z4[pt] = *(const bf16x4*)(proj + (trow0 + l) * NPROJ + 4096 + ch);
    }
    const float al = acs[l * 8 + j];
#pragma unroll
    for (int st = 0; st < 4; ++st) {
      float v[4];
#pragma unroll
      for (int jj = 0; jj < 4; ++jj) {
        const int s = st * 16 + fq * 4 + jj;
        const float e = (s <= l) ? __expf(al - acs[s * 8 + j]) * dts[s * 8 + j] : 0.f;
        v[jj] = cb[st][jj] * e;
      }
      *(uint2*)(SCw + fr * LD64 + st * 16 + fq * 4) = pack4(v[0], v[1], v[2], v[3]);
    }
    __syncthreads();
    f32x4 yd[4], yo[4];
#pragma unroll
    for (int pt = 0; pt < 4; ++pt) yd[pt] = yo[pt] = (f32x4){0.f, 0.f, 0.f, 0.f};
#pragma unroll
    for (int ks = 0; ks < 2; ++ks) {
      bf16x8 sf = *(const bf16x8*)(SCw + fr * LD64 + ks * 32 + fq * 8);
#pragma unroll
      for (int pt = 0; pt < 4; ++pt) {
        bf16x8 xf = *(const bf16x8*)(xt + (pt * 16 + fr) * LD64 + ks * 32 + fq * 8);
        yd[pt] = mfma16(xf, sf, yd[pt]);
      }
    }
#pragma unroll
    for (int ks = 0; ks < 4; ++ks) {
#pragma unroll
      for (int pt = 0; pt < 4; ++pt) yo[pt] = mfma16(sfr[ks][pt], cf[ks], yo[pt]);
    }
    __builtin_amdgcn_sched_barrier(0);
#pragma unroll
    for (int ks = 0; ks < 4; ++ks)
#pragma unroll
      for (int pt = 0; pt < 4; ++pt)
        sfr[ks][pt] = *(const bf16x8*)(ss + (size_t)jn * 8192 + (pt * 16 + fr) * 128 + ks * 32 + fq * 8);
    const float el = __expf(al);
    const float dsk = p.d_skip[g * 8 + j];
#pragma unroll
    for (int pt = 0; pt < 4; ++pt) {
      const int ch = (g * 8 + j) * 64 + pt * 16 + fq * 4;
      bf16_t* zp = proj + (trow0 + l) * NPROJ + 4096 + ch;
      float y[4];
#pragma unroll
      for (int jj = 0; jj < 4; ++jj) {
        y[jj] = (yd[pt][jj] + yo[pt][jj] * el + dsk * bfs2f(x4[pt][jj])) * siluf_(bfs2f(z4[pt][jj]));
        ssq += y[jj] * y[jj];
      }
      if (!dry) *(uint2*)zp = pack4(y[0], y[1], y[2], y[3]);
    }
    __builtin_amdgcn_sched_barrier(0);
#pragma unroll
    for (int i = 0; i < 8; ++i) px[i] = rl[i] | (rh[i] << 16);
  }
  ssq += __shfl_xor(ssq, 16, 64);
  ssq += __shfl_xor(ssq, 32, 64);
  const float rstd = rsqrtf(ssq * (1.f / 512.f) + 1e-6f);
#pragma unroll 1
  for (int j = 0; j < 8; ++j) {
#pragma unroll
    for (int pt = 0; pt < 4; ++pt) {
      const int ch = (g * 8 + j) * 64 + pt * 16 + fq * 4;
      bf16_t* zp = proj + (trow0 + l) * NPROJ + 4096 + ch;
      const bf16x4 y4 = *(const bf16x4*)zp;
      const float4 n4 = *(const float4*)(p.ssm_norm + ch);
      if (!dry) *(uint2*)zp = pack4(bfs2f(y4[0]) * rstd * n4.x, bfs2f(y4[1]) * rstd * n4.y, bfs2f(y4[2]) * rstd * n4.z,
                          bfs2f(y4[3]) * rstd * n4.w);
    }
  }
}

__device__ __forceinline__ void ph_mixA(const P& p, int bid, int nb, char* smem) {
  int it = bid;
  for (; it < 512; it += nb) ssd_phaseA(p, it, smem);
  if (it < 2560) {
    uint32_t pf[16], pv[16];
    {
      const int item = it - 512, k = TIDX & 127, half = TIDX >> 7;
      const bf16_t* proj = (const bf16_t*)(p.ws + OFF_PROJ);
      const size_t trow = (size_t)(item >> 9) * SEQ + (item & 63) * 64 + 32 * half;
      const int h = (item >> 6) & 7;
      load_col32(proj + trow * NPROJ + 1024 + h * 128 + k, pf);
      load_col32(proj + trow * NPROJ + 2048 + h * 128 + k, pv);
    }
    for (; it < 2560; it += nb) hg_phaseA(p, it - 512, smem, pf, pv, it + nb < 2560 ? it + nb - 512 : -1);
  }
}
__device__ __forceinline__ void ph_mixB(const P& p, int bid, int nb, char* smem, int dry) {
  for (int it = bid; it < 2560; it += nb) {
    if (it < 512) ssd_phaseB(p, it, smem, dry);
    else hg_phaseB(p, it - 512, smem, dry);
  }
}
__device__ __forceinline__ void ph_mixS(const P& p, int bid, int nb) {
  for (int gid = bid * 256 + TIDX; gid < 262144; gid += nb * 256) {
    if (gid < 131072) {
      const int bh = gid >> 12, v = (gid >> 5) & 127, kq = gid & 31;
      bf16_t* base = (bf16_t*)(p.ws + OFF_HS) + (size_t)bh * 64 * 16384 + v * 128 + kq * 4;
      const float* hb = (const float*)(p.ws + OFF_HB) + (size_t)bh * 64 * 128 + kq * 4;
      float s0 = 0.f, s1 = 0.f, s2 = 0.f, s3 = 0.f;
#pragma unroll 1
      for (int c0 = 0; c0 < 64; c0 += 8) {
        uint2 d[8];
        float4 bl[8];
#pragma unroll
        for (int j = 0; j < 8; ++j) {
          d[j] = *(const uint2*)(base + (size_t)(c0 + j) * 16384);
          bl[j] = *(const float4*)(hb + (c0 + j) * 128);
        }
#pragma unroll
        for (int j = 0; j < 8; ++j) {
          *(uint2*)(base + (size_t)(c0 + j) * 16384) = pack4(s0, s1, s2, s3);
          s0 = __expf(bl[j].x) * s0 + __uint_as_float(d[j].x << 16);
          s1 = __expf(bl[j].y) * s1 + __uint_as_float(d[j].x & 0xffff0000u);
          s2 = __expf(bl[j].z) * s2 + __uint_as_float(d[j].y << 16);
          s3 = __expf(bl[j].w) * s3 + __uint_as_float(d[j].y & 0xffff0000u);
        }
      }
    } else {
      const int g2 = gid - 131072;
      const int bhd = g2 >> 11, pp = (g2 >> 5) & 63, nq = g2 & 31;
      const int b = bhd >> 4, hd = bhd & 15, g = hd >> 3, j8 = hd & 7;
      const float* sd = (const float*)(p.ws + OFF_SD);
      float s0 = 0.f, s1 = 0.f, s2 = 0.f, s3 = 0.f;
#pragma unroll 1
      for (int c0 = 0; c0 < 64; c0 += 8) {
        uint2 d[8];
        float dec[8];
#pragma unroll
        for (int j = 0; j < 8; ++j) {
          const int item = (b * 2 + g) * 64 + c0 + j;
          d[j] = *(const uint2*)(ssd_state_ptr(p, item) + (size_t)j8 * 8192 + pp * 128 + nq * 4);
          dec[j] = sd[item * 8 + j8];
        }
#pragma unroll
        for (int j = 0; j < 8; ++j) {
          const int item = (b * 2 + g) * 64 + c0 + j;
          *(uint2*)(ssd_state_ptr(p, item) + (size_t)j8 * 8192 + pp * 128 + nq * 4) = pack4(s0, s1, s2, s3);
          s0 = dec[j] * s0 + __uint_as_float(d[j].x << 16);
          s1 = dec[j] * s1 + __uint_as_float(d[j].x & 0xffff0000u);
          s2 = dec[j] * s2 + __uint_as_float(d[j].y << 16);
          s3 = dec[j] * s3 + __uint_as_float(d[j].y & 0xffff0000u);
        }
      }
    }
  }
}
namespace g8 {
constexpr int BM = 256, BK = 64, HALF = 128, HTB = HALF * BK * 2, STAGE_BYTES = 8 * HTB, NXCD = 8, WGM = 8;
__device__ __forceinline__ int lds_byte(int r, int c) {
  const int st = (r >> 4) * 2 + (c >> 5), rr = r & 15, cc = c & 31, ob = rr * 64 + cc * 2;
  return st * 1024 + (ob ^ (((ob >> 9) & 1) << 5));
}
__device__ __forceinline__ void stage_rc(int b, int& R, int& C) {
  const int st = b / 1024, sb = b % 1024, swz = sb ^ (((sb >> 9) & 1) << 5);
  R = (st >> 1) * 16 + swz / 64;
  C = (st & 1) * 32 + (swz % 64) / 2;
}
__device__ __forceinline__ int perm32(int rho) {
  const int n = rho >> 4, i = rho & 15;
  return 8 * (i >> 2) + 4 * n + (i & 3);
}
struct Unit {
  int pm, pn, aux;
  const char* A;
  const char* B;
  long bjb;
  const int* lst;
  int n, slot0, sbase;
  int half;
};
struct Gemm {
  int lda, ldb, K;
  int ajt, bjt;
  long ajb;
};
__device__ __forceinline__ void tile_order(int L, int nM, int nN, int& pm, int& pn) {
  const int nwg = nM * nN;
  int wgid = L;
  {
    const int q = nwg / NXCD, r = nwg % NXCD, xcd = wgid % NXCD, off = wgid / NXCD;
    wgid = (xcd < r ? xcd * (q + 1) : r * (q + 1) + (xcd - r) * q) + off;
  }
  const int nig = WGM * nN, gid = wgid / nig, fm = gid * WGM, gsz = (nM - fm) < WGM ? (nM - fm) : WGM;
  pm = fm + ((wgid % nig) % gsz);
  pn = (wgid % nig) / gsz;
}

template <bool GATHER, class Epi, class Sched>
__device__ __forceinline__ void gemm_phase(LAS unsigned char* lds, const Gemm g, const Sched& S, const Epi& E) {
  const int tid = tid_fresh(), wid = __builtin_amdgcn_readfirstlane(tid >> 6), lane = tid & 63, wr = wid >> 2,
            wc = wid & 3, fr = lane & 15, fq = lane >> 4;
  const int nt = g.K / BK;
  Unit cur, nxt;
  unsigned voffA[2], voffB[2];
  unsigned vA[2][2][2];
#pragma unroll
  for (int i = 0; i < 2; ++i) {
    int R, C;
    stage_rc(tid * 16 + i * 8192, R, C);
    const int Rb = Epi::PERM ? ((R & ~31) + perm32(R & 31)) : R;
    voffA[i] = (unsigned)(R * g.lda + C) * 2u;
    voffB[i] = (unsigned)(Rb * g.ldb + C) * 2u;
  }
  auto gather = [&](const Unit& u, unsigned (&v)[2][2]) {
#pragma unroll
    for (int h = 0; h < 2; ++h)
#pragma unroll
      for (int i = 0; i < 2; ++i) {
        int R, C;
        stage_rc(tid_fresh() * 16 + i * 8192, R, C);
        const int slot = u.slot0 + h * HALF + R;
        const int tok = u.lst[slot < u.n ? slot : 0];
        v[h][i] = (unsigned)(tok * g.lda + C) * 2u;
      }
  };
  const long kstep = (long)(BK * 2);
  const long hstepA = (long)HALF * g.lda * 2, hstepB = (long)HALF * g.ldb * 2;
  const unsigned ldsw = (unsigned)wid * 1024u;
  const int aoff = lds_byte(wr * 64 + fr, fq * 8), boff = lds_byte(wc * 32 + fr, fq * 8);
  auto akoff = [&](int t) -> long { return (long)t * kstep + (t >= g.ajt ? g.ajb : 0l); };
  auto bkoff = [&](int t) -> long { return (long)t * kstep + (t >= g.bjt ? cur.bjb : 0l); };
#define G8_SA(b, h) (((b) * 2 + (h)) * HTB)
#define G8_SB(b, h) ((4 + (b) * 2 + (h)) * HTB)
#define G8_STAGE(bufoff, gbase, voff)                                                                              \
  do {                                                                                                             \
    _Pragma("unroll") for (int _i = 0; _i < 2; ++_i) __builtin_amdgcn_global_load_lds(                           \
        (const unsigned*)((const char*)(gbase) + (voff)[_i]), (LAS unsigned*)(lds + (bufoff) + ldsw + _i * 8192), \
        16, 0, 0);                                                                                                 \
  } while (0)
#define G8_STAGE_A(bufoff, kptr, h, isnext)                                                                        \
  do {                                                                                                             \
    if (GATHER) {                                                                                                  \
      unsigned _v[2];                                                                                              \
      _v[0] = (isnext) ? vA[1][h][0] : vA[0][h][0];                                                                \
      _v[1] = (isnext) ? vA[1][h][1] : vA[0][h][1];                                                                \
      G8_STAGE(bufoff, kptr, _v);                                                                                  \
    } else {                                                                                                       \
      G8_STAGE(bufoff, (kptr) + (h) * hstepA, voffA);                                                              \
    }                                                                                                              \
  } while (0)
#define G8_LDA(dst, b, h)                                                                                 \
  do {                                                                                                    \
    _Pragma("unroll") for (int m = 0; m < 4; ++m) _Pragma("unroll") for (int k = 0; k < 2; ++k) dst[m][k] = \
        *(const LAS bf16x8*)(lds + G8_SA(b, h) + aoff + m * 2048 + k * 1024);                             \
  } while (0)
#define G8_LDB(dst, b, h)                                                                                 \
  do {                                                                                                    \
    _Pragma("unroll") for (int n = 0; n < 2; ++n) _Pragma("unroll") for (int k = 0; k < 2; ++k) dst[n][k] = \
        *(const LAS bf16x8*)(lds + G8_SB(b, h) + boff + n * 2048 + k * 1024);                             \
  } while (0)
#define G8_MMA(ai, bj, At, Bt)                                                                                     \
  do {                                                                                                             \
    __builtin_amdgcn_s_setprio(1);                                                                                 \
    _Pragma("unroll") for (int m = 0; m < 4; ++m) _Pragma("unroll") for (int n = 0; n < 2; ++n)                  \
        _Pragma("unroll") for (int k = 0; k < 2; ++k) acc[ai][bj][m][n] =                                         \
            __builtin_amdgcn_mfma_f32_16x16x32_bf16(Bt[n][k], At[m][k], acc[ai][bj][m][n], 0, 0, 0);               \
    __builtin_amdgcn_s_setprio(0);                                                                                 \
  } while (0)
#define G8_WAIT_V(n) asm volatile("s_waitcnt vmcnt(" #n ")" ::: "memory")
#define G8_WAIT_L(n) asm volatile("s_waitcnt lgkmcnt(" #n ")" ::: "memory")
#define G8_BAR __builtin_amdgcn_s_barrier()
#define G8_SCHED __builtin_amdgcn_sched_barrier(0)
  int ui = 0;
  if (!S.next(0, cur)) return;
  f32x4 acc[2][2][4][2];
#pragma unroll
  for (int a = 0; a < 2; ++a)
#pragma unroll
    for (int b = 0; b < 2; ++b)
#pragma unroll
      for (int m = 0; m < 4; ++m)
#pragma unroll
        for (int n = 0; n < 2; ++n) acc[a][b][m][n] = (f32x4){0.f, 0.f, 0.f, 0.f};
  bf16x8 At[4][2], B0[2][2], B1[2][2];
  const char* cA = cur.A;
  const char* cB = cur.B;
  if (GATHER) gather(cur, vA[0]);
  G8_STAGE(G8_SB(0, 0), cB, voffB);
  G8_STAGE_A(G8_SA(0, 0), cA, 0, false);
  G8_STAGE(G8_SB(0, 1), cB + hstepB, voffB);
  G8_STAGE_A(G8_SA(0, 1), cA, 1, false);
  if (wr == 1) G8_BAR;
  G8_WAIT_V(4);
  G8_BAR;
  G8_STAGE(G8_SB(1, 0), cB + kstep, voffB);
  G8_STAGE_A(G8_SA(1, 0), cA + kstep, 0, false);
  G8_STAGE(G8_SB(1, 1), cB + hstepB + kstep, voffB);
  G8_WAIT_V(6);
  G8_BAR;
  for (;;) {
    const bool has_next = S.next(ui + 1, nxt);
    const bool hf = Sched::HALFSKIP && __builtin_amdgcn_readfirstlane(cur.half) != 0;
    const char* nA = has_next ? nxt.A : cA;
    const char* nB = has_next ? nxt.B : cB;
    if (GATHER) {
      if (has_next) gather(nxt, vA[1]);
      else {
#pragma unroll
        for (int h = 0; h < 2; ++h)
#pragma unroll
          for (int i = 0; i < 2; ++i) vA[1][h][i] = vA[0][h][i];
      }
    }
    for (int t = 0; t < nt; t += 2) {
      const bool last = (t == nt - 2);
      const char* a1 = cA + akoff(t + 1);
      const char* a2 = last ? nA : cA + akoff(t + 2);
      const char* b2 = last ? nB : cB + bkoff(t + 2);
      const char* a3 = last ? nA + kstep : cA + akoff(t + 3);
      const char* b3 = last ? nB + kstep : cB + bkoff(t + 3);
      G8_LDB(B0, 0, 0); G8_SCHED; G8_LDA(At, 0, 0); G8_STAGE_A(G8_SA(1, 1), a1, 1, false);
      G8_WAIT_L(8); G8_BAR; G8_WAIT_L(0); G8_MMA(0, 0, At, B0); G8_BAR; G8_SCHED;
      G8_LDB(B1, 0, 1); G8_STAGE(G8_SB(0, 0), b2, voffB);
      G8_BAR; G8_WAIT_L(0); G8_MMA(0, 1, At, B1); G8_BAR;
      if (!hf) G8_LDA(At, 0, 1);
      G8_STAGE_A(G8_SA(0, 0), a2, 0, last);
      G8_BAR; G8_WAIT_L(0); if (!hf) G8_MMA(1, 0, At, B0); G8_BAR; G8_SCHED;
      G8_STAGE(G8_SB(0, 1), b2 + hstepB, voffB);
      G8_WAIT_V(6); G8_BAR; if (!hf) G8_MMA(1, 1, At, B1); G8_BAR;
      G8_LDB(B0, 1, 0); G8_SCHED; G8_LDA(At, 1, 0); G8_STAGE_A(G8_SA(0, 1), a2, 1, last);
      G8_WAIT_L(8); G8_BAR; G8_WAIT_L(0); G8_MMA(0, 0, At, B0); G8_BAR; G8_SCHED;
      G8_LDB(B1, 1, 1); G8_STAGE(G8_SB(1, 0), b3, voffB);
      G8_BAR; G8_WAIT_L(0); G8_MMA(0, 1, At, B1); G8_BAR;
      if (!hf) G8_LDA(At, 1, 1);
      G8_STAGE_A(G8_SA(1, 0), a3, 0, last);
      G8_BAR; G8_WAIT_L(0); if (!hf) G8_MMA(1, 0, At, B0); G8_BAR; G8_SCHED;
      G8_STAGE(G8_SB(1, 1), b3 + hstepB, voffB);
      G8_WAIT_V(6); G8_BAR; if (!hf) G8_MMA(1, 1, At, B1); G8_BAR;
    }
    E(acc, cur, wr, wc, fr, fq);
    if (!has_next) break;
#pragma unroll
    for (int a = 0; a < 2; ++a)
#pragma unroll
      for (int b = 0; b < 2; ++b)
#pragma unroll
        for (int m = 0; m < 4; ++m)
#pragma unroll
          for (int n = 0; n < 2; ++n) acc[a][b][m][n] = (f32x4){0.f, 0.f, 0.f, 0.f};
    cur = nxt;
    cA = nA;
    cB = nB;
    if (GATHER) {
#pragma unroll
      for (int h = 0; h < 2; ++h)
#pragma unroll
        for (int i = 0; i < 2; ++i) vA[0][h][i] = vA[1][h][i];
    }
    ++ui;
  }
  G8_WAIT_V(0);
  if (wr == 0) G8_BAR;
  G8_BAR;
#undef G8_SA
#undef G8_SB
#undef G8_STAGE
#undef G8_STAGE_A
#undef G8_LDA
#undef G8_LDB
#undef G8_MMA
#undef G8_WAIT_V
#undef G8_WAIT_L
#undef G8_BAR
#undef G8_SCHED
}

struct EpiBf16 {
  static constexpr bool PERM = true;
  bf16_t* O;
  int ldc;
  long unit_stride;
  __device__ __forceinline__ void operator()(const f32x4 (&acc)[2][2][4][2], const Unit& u, int wr, int wc, int fr,
                                             int fq) const {
    const int row0 = u.pm * BM + u.slot0 + wr * 64 + fr, col0 = u.pn * BM + wc * 32 + 8 * fq;
    bf16_t* base = O + (long)u.aux * unit_stride;
#pragma unroll
    for (int ai = 0; ai < 2; ++ai) {
      if (ai == 1 && u.half) break;
#pragma unroll
      for (int m = 0; m < 4; ++m) {
        bf16_t* rowp = base + (long)(row0 + ai * HALF + m * 16) * ldc + col0;
#pragma unroll
        for (int bj = 0; bj < 2; ++bj) {
          const f32x4 v0 = acc[ai][bj][m][0], v1 = acc[ai][bj][m][1];
          uint4 o;
          o.x = pack2(v0[0], v0[1]);
          o.y = pack2(v0[2], v0[3]);
          o.z = pack2(v1[0], v1[1]);
          o.w = pack2(v1[2], v1[3]);
          *(uint4*)(rowp + bj * HALF) = o;
        }
      }
    }
  }
};
struct EpiResid {
  static constexpr bool PERM = false;
  const float* base;
  float* out;
  const float* gate;
  int dry;
  __device__ __forceinline__ void operator()(const f32x4 (&acc)[2][2][4][2], const Unit& u, int wr, int wc, int fr,
                                             int fq) const {
    const int row0 = u.pm * BM + wr * 64 + fr, col0 = u.pn * BM + wc * 32 + 4 * fq;
    const float* gt = gate + (long)(u.pm >> 4) * 6144 + col0;
    f32x4 gv[2][2];
#pragma unroll
    for (int bj = 0; bj < 2; ++bj)
#pragma unroll
      for (int n = 0; n < 2; ++n) gv[bj][n] = *(const f32x4*)(gt + bj * HALF + n * 16);
#pragma unroll
    for (int ai = 0; ai < 2; ++ai)
#pragma unroll
      for (int m = 0; m < 4; ++m) {
        const long ro = (long)(row0 + ai * HALF + m * 16) * 1024 + col0;
#pragma unroll
        for (int bj = 0; bj < 2; ++bj)
#pragma unroll
          for (int n = 0; n < 2; ++n) {
            const f32x4 b4 = *(const f32x4*)(base + ro + bj * HALF + n * 16);
            if (!dry) *(f32x4*)(out + ro + bj * HALF + n * 16) = b4 + gv[bj][n] * acc[ai][bj][m][n];
          }
      }
  }
};
struct StaticSched {
  static constexpr bool HALFSKIP = false;
  const char* A;
  const char* B;
  long strideA, strideB, tstepA, tstepB;
  int nM, nN, nprob, G, c;
  __device__ __forceinline__ bool next(int i, Unit& u) const {
    const int L = i * G + c, per = nM * nN;
    if (L >= per * nprob) return false;
    const int pr = L / per;
    tile_order(L - pr * per, nM, nN, u.pm, u.pn);
    u.aux = pr;
    u.A = A + (long)pr * strideA + (long)u.pm * tstepA;
    u.B = B + (long)pr * strideB + (long)u.pn * tstepB;
    u.bjb = 0;
    u.lst = nullptr;
    u.n = 0;
    u.slot0 = 0;
    u.sbase = 0;
    u.half = 0;
    return true;
  }
};
struct StaticSplitSched {
  static constexpr bool HALFSKIP = true;
  const char* A;
  const char* B;
  long tstepA, tstepB;
  int nM, nN, G, c;
  __device__ __forceinline__ bool next(int i, Unit& u) const {
    const int L = i * G + c, U = nM * nN, full = (U / G) * G, rem = U - full;
    const bool split = rem > 0 && 2 * rem <= G;
    int base = L, h = 0, hf = 0;
    if (split && L >= full) {
      const int j = L - full;
      if (j >= 2 * rem) return false;
      base = full + (j >> 1);
      h = j & 1;
      hf = 1;
    } else if (L >= U) {
      return false;
    }
    tile_order(base, nM, nN, u.pm, u.pn);
    u.aux = 0;
    u.A = A + (long)u.pm * tstepA + (long)h * (tstepA >> 1);
    u.B = B + (long)u.pn * tstepB;
    u.bjb = 0;
    u.lst = nullptr;
    u.n = 0;
    u.slot0 = h * HALF;
    u.sbase = 0;
    u.half = hf;
    return true;
  }
};
}

__device__ __forceinline__ void ph8_inproj(const P& p, LAS unsigned char* lds) {
  g8::Gemm g{1024, 1024, 1024, 1 << 20, 1 << 20, 0};
  g8::StaticSplitSched S{(const char*)(p.ws + OFF_S1), (const char*)(p.ws + OFF_WINT), 256l * 1024 * 2,
                         256l * 1024 * 2, 64, 26, (int)gridDim.x, (int)blockIdx.x};
  g8::EpiBf16 E{(bf16_t*)(p.ws + OFF_PROJ), NPROJ, 0};
  g8::gemm_phase<false>(lds, g, S, E);
}
__device__ __forceinline__ void ph8_outproj(const P& p, LAS unsigned char* lds) {
  g8::Gemm g{NPROJ, 2048, 2048, 16, 1 << 20, 3072l * 2};
  g8::StaticSched S{(const char*)(p.ws + OFF_PROJ), (const char*)(p.ws + OFF_WOUTT), 0, 0, 256l * NPROJ * 2,
                    256l * 2048 * 2, 64, 4, 1, (int)gridDim.x, (int)blockIdx.x};
  g8::EpiResid E{p.x, p.out, (const float*)(p.ws + OFF_MOD) + 2048, 0};
  g8::gemm_phase<false>(lds, g, S, E);
}
__device__ __forceinline__ void ph8_rkv(const P& p, LAS unsigned char* lds) {
  g8::Gemm g{1024, 1024, 1024, 1 << 20, 1 << 20, 0};
  g8::StaticSched S{(const char*)(p.ws + OFF_KK), (const char*)(p.ws + OFF_WRKVT), (long)(32 * MiB), 1024l * 1024 * 2,
                    256l * 1024 * 2, 256l * 1024 * 2, 64, 4, 3, (int)gridDim.x, (int)blockIdx.x};
  g8::EpiBf16 E{(bf16_t*)(p.ws + OFF_R), 1024, (long)(16 * MiB)};
  g8::gemm_phase<false>(lds, g, S, E);
}
__device__ __forceinline__ void ph8_wo(const P& p, LAS unsigned char* lds, int dry = 0) {
  g8::Gemm g{1024, 1024, 1024, 1 << 20, 1 << 20, 0};
  g8::StaticSched S{(const char*)(p.ws + OFF_S1), (const char*)(p.ws + OFF_WOT), 0, 0, 256l * 1024 * 2,
                    256l * 1024 * 2, 64, 4, 1, (int)gridDim.x, (int)blockIdx.x};
  g8::EpiResid E{p.out, p.out, (const float*)(p.ws + OFF_MOD) + 4 * 6144 + 2048, dry};
  g8::gemm_phase<false>(lds, g, S, E);
}

__device__ __forceinline__ int route_one(const P& p, int t, float logit_lane, int lane, float* gates) {
    float lg[16];
#pragma unroll
    for (int j = 0; j < 16; ++j)
      lg[j] = __int_as_float(__builtin_amdgcn_readlane(__float_as_int(logit_lane), j)) + p.router_b[j];
    float mx = -1e30f;
#pragma unroll
    for (int j = 0; j < 16; ++j) mx = fmaxf(mx, lg[j]);
    float sum = 0.f;
#pragma unroll
    for (int j = 0; j < 16; ++j) {
      lg[j] = __expf(lg[j] - mx);
      sum += lg[j];
    }
    float inv = 1.f / sum;
#pragma unroll
    for (int j = 0; j < 16; ++j) lg[j] *= inv;
    int best = 0;
    float bests = -1.f;
    float q0 = 0, q1 = 0, q2 = 0, q3 = 0;
#pragma unroll
    for (int g = 0; g < 4; ++g) {
      float a0 = lg[g * 4], a1 = lg[g * 4 + 1], a2 = lg[g * 4 + 2], a3 = lg[g * 4 + 3];
      float hi01 = fmaxf(a0, a1), lo01 = fminf(a0, a1), hi23 = fmaxf(a2, a3), lo23 = fminf(a2, a3);
      float m1 = fmaxf(hi01, hi23);
      float m2 = fmaxf(fminf(hi01, hi23), fmaxf(lo01, lo23));
      float s = m1 + m2;
      if (s > bests) {
        bests = s;
        best = g;
        q0 = a0;
        q1 = a1;
        q2 = a2;
        q3 = a3;
      }
    }
    int i1 = 0;
    float v1 = q0;
    if (q1 > v1) { v1 = q1; i1 = 1; }
    if (q2 > v1) { v1 = q2; i1 = 2; }
    if (q3 > v1) { v1 = q3; i1 = 3; }
    int i2 = -1;
    float v2 = -1.f;
    if (i1 != 0 && q0 > v2) { v2 = q0; i2 = 0; }
    if (i1 != 1 && q1 > v2) { v2 = q1; i2 = 1; }
    if (i1 != 2 && q2 > v2) { v2 = q2; i2 = 2; }
    if (i1 != 3 && q3 > v2) { v2 = q3; i2 = 3; }
    float wsum = v1 + v2;
    float g1 = v1 / wsum, g2 = v2 / wsum;
    int lo = i1 < i2 ? i1 : i2, hi = i1 < i2 ? i2 : i1;
    float glo = i1 < i2 ? g1 : g2, ghi = i1 < i2 ? g2 : g1;
    int pidx = (lo == 0) ? (hi - 1) : ((lo == 1) ? (hi + 1) : 5);
    int combo = best * 6 + pidx;
    if (lane == 0) {
      gates[(size_t)t * 2] = glo;
      gates[(size_t)t * 2 + 1] = ghi;
    }
    return combo;
}

__device__ __forceinline__ void ph_route(const P& p, int layer, int bid, int nb, char* smem) {
  float* tb = (float*)(smem - ((tid_fresh() >> 8) * 65536));
  const float* mod = (const float*)(p.ws + OFF_MOD) + (size_t)layer * 4 * 6144;
  tok_fill_tables(tb, p.norm_w + (layer * 2 + 1) * 1024, mod + 3072, mod + 4096, p.router_w, 16);
  const int tf = tid_fresh(), lane = tf & 63, gw = (bid >> 1) * 8 + (tf >> 6), nw = (nb >> 1) * 8;
  bf16_t* hbf = (bf16_t*)(p.ws + OFF_S1);
  int* cnt = (int*)(p.ws + OFF_CNTP) + layer * CNT_LAYER;
  int* list = (int*)(p.ws + OFF_LIST);
  float* gates = (float*)(p.ws + OFF_GATES);
  int* lcnt = (int*)(tb + 24576);
  int* lbase = lcnt + 32;
  const int niter = (T / 8 + nw - 1) / nw;
  for (int it = 0, ch = gw; it < niter; ++it, ch += nw) {
    if (tf < 24) lcnt[tf] = 0;
    __syncthreads();
    const bool act = ch < T / 8;
    const int t0 = ch * 8, b = t0 >> 12;
    int mycombo = 0, myrank = 0;
    if (act) {
    float4 va0[4], va1[4];
    rows2_load(p.out + (size_t)t0 * 1024, p.out + (size_t)(t0 + 1) * 1024, lane, va0, va1);
#pragma unroll 1
    for (int tt = 0; tt < 8; tt += 2) {
      const int t = t0 + tt;
      float4 vb0[4], vb1[4];
      const int tn = (tt + 2 < 8) ? t + 2 : t;
      rows2_load(p.out + (size_t)tn * 1024, p.out + (size_t)(tn + 1) * 1024, lane, vb0, vb1);
      float h0[16], h1[16], a0[16], a1[16];
      norm2_calc(va0, va1, tb, b, lane, h0, h1);
#pragma unroll
      for (int i = 0; i < 4; ++i) {
        va0[i] = vb0[i];
        va1[i] = vb1[i];
      }
      store_hbf(hbf + (size_t)t * 1024, lane, h0);
      store_hbf(hbf + (size_t)(t + 1) * 1024, lane, h1);
      dots2(tb, lane, h0, h1, a0, a1);
      const float d0 = xpose_reduce16(a0, lane), d1 = xpose_reduce16(a1, lane);
      const int c0 = route_one(p, t, d0, lane, gates);
      const int c1 = route_one(p, t + 1, d1, lane, gates);
      mycombo = lane == tt ? c0 : (lane == tt + 1 ? c1 : mycombo);
    }
    if (lane < 8) myrank = atomicAdd(&lcnt[mycombo], 1);
    }
    __syncthreads();
    if (tf < 24) {
      const int c = lcnt[tf];
      lbase[tf] = c > 0 ? atomicAdd(&cnt[tf * CNT_STRIDE], c) : 0;
    }
    __syncthreads();
    if (act && lane < 8) list[(size_t)mycombo * T + lbase[mycombo] + myrank] = t0 + lane;
  }
}

struct MoeMap {
  int pre[25];
};
__device__ __forceinline__ void moe_find(const int* cnt, int tg, int& combo, int& mt, int& n, int& sbase) {
  int acc = 0;
  combo = 0;
  mt = 0;
  n = 0;
  sbase = 0;
  bool found = false;
  for (int c = 0; c < 24; ++c) {
    int cc = cnt[c];
    int nt = (cc + 127) >> 7;
    if (!found && tg < acc + nt) {
      combo = c;
      mt = tg - acc;
      n = cc;
      sbase = acc * 128;
      found = true;
    }
    acc += nt;
  }
}
__device__ __forceinline__ int moe_total_tiles(const int* cnt) {
  int acc = 0;
  for (int c = 0; c < 24; ++c) acc += (cnt[c] + 127) >> 7;
  return acc;
}
__device__ __forceinline__ void combo_experts(int combo, int& e1, int& e2) {
  int g = combo / 6, pi = combo % 6;
  int lo = pi < 3 ? 0 : (pi < 5 ? 1 : 2);
  int hi = pi < 3 ? pi + 1 : (pi < 5 ? pi - 1 : 3);
  e1 = g * 4 + lo;
  e2 = g * 4 + hi;
}

__device__ __forceinline__ void ph_moe_up(const P& p, int layer, int bid, int nb, char* smem) {
  const int* cnt = (const int*)(p.ws + OFF_CNT) + layer * 32;
  const int* list = (const int*)(p.ws + OFF_LIST);
  const float* gates = (const float*)(p.ws + OFF_GATES);
  const bf16_t* hbf = (const bf16_t*)(p.ws + OFF_S1);
  const bf16_t* W13 = (const bf16_t*)(p.ws + OFF_W13T);
  bf16_t* hid = (bf16_t*)(p.ws + OFF_HID);
  const int TT = moe_total_tiles(cnt);
  const int tid = TIDX;
  for (int w = bid; w < TT * 16; w += nb) {
    int tg = w >> 4, nt = w & 15;
    int combo, mt, n, sbase;
    moe_find(cnt, tg, combo, mt, n, sbase);
    int e1, e2;
    combo_experts(combo, e1, e2);
    const int e = nt < 8 ? e1 : e2;
    const int* lst = list + (size_t)combo * T;
    const bf16_t* Bb = W13 + (size_t)e * 1048576 + (size_t)(nt & 7) * 128 * 1024;
    const bf16_t* arow[4];
#pragma unroll
    for (int i = 0; i < 4; ++i) {
      int slot = mt * 128 + (tid >> 3) + 32 * i;
      int tok = lst[slot < n ? slot : 0];
      arow[i] = hbf + (size_t)tok * 1024;
    }
    gemm_tile([&](int i, int r, int k) { return *(const bf16x8*)(arow[i] + k); },
              [&](int i, int r, int k) { return *(const bf16x8*)(Bb + (size_t)r * 1024 + k); }, 16,
              [&](f32x4(&acc)[4][4], int r0, int c0) {
                const int wc = c0 >> 6, fq = (c0 >> 4) & 3;
                const int hc = (nt >> 3) * 512 + (nt & 7) * 64 + wc * 32 + fq * 8;
#pragma unroll
                for (int m = 0; m < 4; ++m) {
                  int slot = mt * 128 + r0 + m * 16;
                  int tok = lst[slot < n ? slot : 0];
                  float gate = gates[(size_t)tok * 2 + (nt >> 3)];
                  bf16x8 o8;
#pragma unroll
                  for (int np = 0; np < 2; ++np)
#pragma unroll
                    for (int j = 0; j < 4; ++j)
                      o8[np * 4 + j] = (short)f2bf(siluf_(acc[m][2 * np][j]) * acc[m][2 * np + 1][j] * gate);
                  *(bf16x8*)(hid + (size_t)(sbase + slot) * 1024 + hc) = o8;
                }
              },
              smem);
  }
}

__device__ __forceinline__ void ph_moe_down(const P& p, int layer, int bid, int nb, char* smem) {
  const int* cnt = (const int*)(p.ws + OFF_CNT) + layer * 32;
  const int* list = (const int*)(p.ws + OFF_LIST);
  const float* mod = (const float*)(p.ws + OFF_MOD);
  const bf16_t* W2 = (const bf16_t*)(p.ws + OFF_W2T);
  const bf16_t* hid = (const bf16_t*)(p.ws + OFF_HID);
  const int TT = moe_total_tiles(cnt);
  for (int w = bid; w < TT * 8; w += nb) {
    int tg = w >> 3, nt = w & 7;
    int combo, mt, n, sbase;
    moe_find(cnt, tg, combo, mt, n, sbase);
    int e1, e2;
    combo_experts(combo, e1, e2);
    const int* lst = list + (size_t)combo * T;
    const bf16_t* Ab = hid + (size_t)(sbase + mt * 128) * 1024;
    const bf16_t* B1 = W2 + (size_t)e1 * 524288 + (size_t)nt * 128 * 512;
    const bf16_t* B2 = W2 + (size_t)e2 * 524288 + (size_t)nt * 128 * 512;
    gemm_tile([&](int i, int r, int k) { return *(const bf16x8*)(Ab + (size_t)r * 1024 + k); },
              [&](int i, int r, int k) {
                return k < 512 ? *(const bf16x8*)(B1 + (size_t)r * 512 + k)
                               : *(const bf16x8*)(B2 + (size_t)r * 512 + (k - 512));
              },
              16,
              [&](f32x4(&acc)[4][4], int r0, int c0) {
#pragma unroll
                for (int m = 0; m < 4; ++m) {
                  int slot = mt * 128 + r0 + m * 16;
                  if (slot < n) {
                    int tok = lst[slot];
                    const float* gt = mod + (size_t)(layer * 4 + (tok >> 12)) * 6144 + 5120 + nt * 128 + c0;
                    float* orow = p.out + (size_t)tok * 1024 + nt * 128 + c0;
#pragma unroll
                    for (int nn = 0; nn < 4; ++nn) {
                      float4 base = *(const float4*)(orow + nn * 4);
                      float4 g4 = *(const float4*)(gt + nn * 4);
                      base.x += g4.x * acc[m][nn][0];
                      base.y += g4.y * acc[m][nn][1];
                      base.z += g4.z * acc[m][nn][2];
                      base.w += g4.w * acc[m][nn][3];
                      *(float4*)(orow + nn * 4) = base;
                    }
                  }
                }
              },
              smem);
  }
}

namespace g8 {
struct MoeSched {
  static constexpr bool HALFSKIP = true;
  const int* cnt;
  const int* list;
  const char* A;
  const char* B;
  int nu;
  int up;
  int G, c;
  __device__ __forceinline__ bool next(int i, Unit& u) const {
    const int L = i * G + c;
    const int tg = L / nu, ng = L % nu;
    int TT = 0, NH = 0;
    for (int q = 0; q < 24; ++q) {
      const int cc = cnt[q * CNT_STRIDE];
      TT += (cc + 255) >> 8;
      NH += (cc > 0 && ((cc - 1) & 255) < 128) ? 1 : 0;
    }
    if (tg >= TT) return false;
    const int NB = TT - NH;
    int acc = 0, bacc = 0, hacc = 0, combo = -1, mt = 0, n = 0, hf = 0;
    for (int q = 0; q < 24; ++q) {
      const int cc = cnt[q * CNT_STRIDE];
      const int ntl = (cc + 255) >> 8;
      const int hq = (cc > 0 && ((cc - 1) & 255) < 128) ? 1 : 0;
      const int nbq = ntl - hq;
      if (combo < 0) {
        if (tg < NB) {
          if (tg < bacc + nbq) {
            combo = q;
            mt = tg - bacc;
            n = cc;
          }
        } else if (hq && tg - NB == hacc) {
          combo = q;
          mt = ntl - 1;
          n = cc;
          hf = 1;
        }
        if (combo < 0) {
          acc += ntl;
          bacc += nbq;
          hacc += hq;
        }
      }
    }
    if (combo < 0) return false;
    int e1, e2;
    combo_experts(combo, e1, e2);
    u.pm = mt;
    u.pn = ng;
    u.lst = list + (long)combo * T;
    u.n = n;
    u.slot0 = mt * 256;
    u.sbase = acc * 256;
    u.half = hf;
    if (up) {
      const int e = ng < 4 ? e1 : e2;
      u.aux = ng >> 2;
      u.A = A;
      u.B = B + ((long)e * 1024 + (long)(ng & 3) * 256) * 1024 * 2;
      u.bjb = 0;
    } else {
      u.aux = 0;
      u.A = A + (long)(u.sbase + u.slot0) * 1024 * 2;
      u.B = B + ((long)e1 * 1024 + (long)ng * 256) * 512 * 2;
      u.bjb = (long)(e2 - e1) * 1024 * 512 * 2 - 512 * 2;
    }
    return true;
  }
};
struct EpiMoeUp {
  static constexpr bool PERM = false;
  bf16_t* hid;
  const float* gates;
  __device__ __forceinline__ void operator()(const f32x4 (&acc)[2][2][4][2], const Unit& u, int wr, int wc, int fr,
                                             int fq) const {
    const int hc0 = u.aux * 512 + (u.pn & 3) * 128 + wc * 16 + 4 * fq;
#pragma unroll
    for (int ai = 0; ai < 2; ++ai) {
      if (ai == 1 && u.half) break;
#pragma unroll
      for (int m = 0; m < 4; ++m) {
        const int slot = u.slot0 + ai * HALF + wr * 64 + m * 16 + fr;
        const int tok = u.lst[slot < u.n ? slot : 0];
        const float gate = gates[(long)tok * 2 + u.aux];
        bf16_t* rowp = hid + (long)(u.sbase + slot) * 1024 + hc0;
#pragma unroll
        for (int bj = 0; bj < 2; ++bj) {
          const f32x4 a1 = acc[ai][bj][m][0], a3 = acc[ai][bj][m][1];
          *(uint2*)(rowp + bj * 64) = pack4(siluf_(a1[0]) * a3[0] * gate, siluf_(a1[1]) * a3[1] * gate,
                                            siluf_(a1[2]) * a3[2] * gate, siluf_(a1[3]) * a3[3] * gate);
        }
      }
    }
  }
};
struct EpiMoeDown {
  static constexpr bool PERM = false;
  float* out;
  const float* gate;
  int dry;
  __device__ __forceinline__ void operator()(const f32x4 (&acc)[2][2][4][2], const Unit& u, int wr, int wc, int fr,
                                             int fq) const {
    const int col0 = u.pn * BM + wc * 32 + 4 * fq;
#pragma unroll
    for (int ai = 0; ai < 2; ++ai)
#pragma unroll
      for (int m = 0; m < 4; ++m) {
        const int slot = u.slot0 + ai * HALF + wr * 64 + m * 16 + fr;
        if (slot < u.n) {
          const int tok = u.lst[slot];
          const float* gt = gate + (long)(tok >> 12) * 6144 + col0;
          float* orow = out + (long)tok * 1024 + col0;
#pragma unroll
          for (int bj = 0; bj < 2; ++bj)
#pragma unroll
            for (int n = 0; n < 2; ++n) {
              const f32x4 g4 = *(const f32x4*)(gt + bj * HALF + n * 16);
              const f32x4 b4 = *(const f32x4*)(orow + bj * HALF + n * 16);
              if (!dry) *(f32x4*)(orow + bj * HALF + n * 16) = b4 + g4 * acc[ai][bj][m][n];
            }
        }
      }
  }
};
}

__device__ __forceinline__ void ph8_moe_up(const P& p, int layer, LAS unsigned char* lds) {
  g8::Gemm g{1024, 1024, 1024, 1 << 20, 1 << 20, 0};
  g8::MoeSched S{(const int*)(p.ws + OFF_CNTP) + layer * CNT_LAYER, (const int*)(p.ws + OFF_LIST), (const char*)(p.ws + OFF_S1),
                 (const char*)(p.ws + (layer ? OFF_W13T_L1 : OFF_W13T)), 8, 1, (int)gridDim.x, (int)blockIdx.x};
  g8::EpiMoeUp E{(bf16_t*)(p.ws + OFF_HID), (const float*)(p.ws + OFF_GATES)};
  g8::gemm_phase<true>(lds, g, S, E);
}
__device__ __forceinline__ void ph8_moe_down(const P& p, int layer, LAS unsigned char* lds, int dry = 0) {
  g8::Gemm g{1024, 512, 1024, 1 << 20, 8, 0};
  g8::MoeSched S{(const int*)(p.ws + OFF_CNTP) + layer * CNT_LAYER, (const int*)(p.ws + OFF_LIST), (const char*)(p.ws + OFF_HID),
                 (const char*)(p.ws + (layer ? OFF_W2T_L1 : OFF_W2T)), 4, 0, (int)gridDim.x, (int)blockIdx.x};
  g8::EpiMoeDown E{p.out, (const float*)(p.ws + OFF_MOD) + (long)layer * 4 * 6144 + 5120, dry};
  g8::gemm_phase<false>(lds, g, S, E);
}

__device__ __forceinline__ void ph_norm1(const P& p, int bid, int nb, char* smem) {
  float* tb = (float*)(smem - ((tid_fresh() >> 8) * 65536));
  const float* mod = (const float*)(p.ws + OFF_MOD) + (size_t)4 * 6144;
  tok_fill_tables(tb, p.norm_w + 2 * 1024, mod, mod + 1024, nullptr, 0);
  {
    const int t = tid_fresh();
    for (int i = t; i < 3072; i += 512) tb[8192 + i] = p.mu[i];
    __syncthreads();
  }
  const int tf = tid_fresh(), lane = tf & 63, gw = (bid >> 1) * 8 + (tf >> 6), nw = (nb >> 1) * 8;
  bf16_t* hbf = (bf16_t*)(p.ws + OFF_S1);
  bf16_t* mx0 = (bf16_t*)(p.ws + OFF_KK);
  bf16_t* mx1 = (bf16_t*)(p.ws + OFF_AA);
  bf16_t* mx2 = (bf16_t*)(p.ws + OFF_G);
  auto emit = [&](int t, const float (&h)[16], const float (&hp)[16]) {
    store_hbf(hbf + (size_t)t * 1024, lane, h);
#pragma unroll
    for (int i = 0; i < 4; ++i) {
      const int d0 = (lane + 64 * i) * 4;
      const float4 mu0 = *(const float4*)(tb + 8192 + d0), mu1 = *(const float4*)(tb + 8192 + 1024 + d0),
                   mu2 = *(const float4*)(tb + 8192 + 2048 + d0);
      const float x0 = hp[i * 4] - h[i * 4], x1 = hp[i * 4 + 1] - h[i * 4 + 1], x2 = hp[i * 4 + 2] - h[i * 4 + 2],
                  x3 = hp[i * 4 + 3] - h[i * 4 + 3];
      *(uint2*)(mx0 + (size_t)t * 1024 + d0) = pack4(h[i * 4] + x0 * mu0.x, h[i * 4 + 1] + x1 * mu0.y,
                                                     h[i * 4 + 2] + x2 * mu0.z, h[i * 4 + 3] + x3 * mu0.w);
      *(uint2*)(mx1 + (size_t)t * 1024 + d0) = pack4(h[i * 4] + x0 * mu1.x, h[i * 4 + 1] + x1 * mu1.y,
                                                     h[i * 4 + 2] + x2 * mu1.z, h[i * 4 + 3] + x3 * mu1.w);
      *(uint2*)(mx2 + (size_t)t * 1024 + d0) = pack4(h[i * 4] + x0 * mu2.x, h[i * 4 + 1] + x1 * mu2.y,
                                                     h[i * 4 + 2] + x2 * mu2.z, h[i * 4 + 3] + x3 * mu2.w);
    }
  };
  for (int ch = gw; ch < T / 8; ch += nw) {
    const int t0 = ch * 8, b = t0 >> 12;
    const bool first = (t0 & (SEQ - 1)) == 0;
    float hc[16];
#pragma unroll
    for (int j = 0; j < 16; ++j) hc[j] = 0.f;
#pragma unroll 1
    for (int k = 0; k < 5; ++k) {
      int ra = t0 - 1 + 2 * k, rb = t0 + 2 * k;
      if (k == 0 && first) ra = t0;
      if (k == 4) rb = t0 + 7;
      float ha[16], hb[16];
      norm2(p.out + (size_t)ra * 1024, p.out + (size_t)rb * 1024, tb, b, lane, ha, hb);
      if (k == 0 && first) {
#pragma unroll
        for (int j = 0; j < 16; ++j) ha[j] = 0.f;
      }
      if (k >= 1) emit(ra, ha, hc);
      if (k <= 3) emit(rb, hb, ha);
#pragma unroll
      for (int j = 0; j < 16; ++j) hc[j] = hb[j];
    }
  }
}

__device__ __forceinline__ void ph_gemm_rkv(const P& p, int bid, int nb, char* smem) {
  const bf16_t* hbf = (const bf16_t*)(p.ws + OFF_S1);
  const bf16_t* W = (const bf16_t*)(p.ws + OFF_WRKVT);
  const bf16_t* L1T = (const bf16_t*)(p.ws + OFF_LORA1T);
  bf16_t* lora1 = (bf16_t*)(p.ws + OFF_LORA1);
  const int kh = bid & 1;
  char* base_lds = smem - kh * 65536;
  float* sums = (float*)(base_lds + 65536);
  for (int w = bid >> 1; w < 128 * 2; w += nb >> 1) {
    int mt = w % 128, nt = w / 128 + 24;
    const int m0 = mt * 128;
    {
      const int n0 = (nt - 24) * 128;
      const bf16_t* Bb = L1T + (size_t)n0 * 2048 + kh * 1024;
      gemm_tile(
          [&](int i, int r, int k) {
            int t = m0 + r;
            bf16x8 v = *(const bf16x8*)(hbf + ((long)t - kh) * 1024 + k);
            if (kh && (t & (SEQ - 1)) == 0) v = (bf16x8){0, 0, 0, 0, 0, 0, 0, 0};
            return v;
          },
          [&](int i, int r, int k) { return *(const bf16x8*)(Bb + (size_t)r * 2048 + k); }, 16,
          [&](f32x4(&acc)[4][4], int r0, int c0) {
            const int tl = TIDX;
            __syncthreads();
            if (kh == 1) {
#pragma unroll
              for (int m = 0; m < 4; ++m)
#pragma unroll
                for (int n = 0; n < 4; ++n) *(f32x4*)(sums + ((m * 4 + n) * 256 + tl) * 4) = acc[m][n];
            }
            __syncthreads();
            if (kh == 0) {
              const int colb = n0 + c0;
#pragma unroll
              for (int m = 0; m < 4; ++m) {
#pragma unroll
                for (int n = 0; n < 4; ++n) {
                  const f32x4 o = *(const f32x4*)(sums + ((m * 4 + n) * 256 + tl) * 4);
#pragma unroll
                  for (int j = 0; j < 4; ++j) {
                    float v = acc[m][n][j] + o[j];
                    acc[m][n][j] = colb < 64 ? 1.f - 2.f / (__expf(2.f * v) + 1.f) : (colb < 128 ? v : sigmoidf_(v));
                  }
                }
                store16(lora1 + (size_t)(m0 + r0 + m * 16) * 256 + colb, acc[m]);
              }
            }
          },
          smem);
    }
  }
}

__device__ __forceinline__ void ph_gemm_lora2(const P& p, int bid, int nb, char* smem) {
  const bf16_t* lora1 = (const bf16_t*)(p.ws + OFF_LORA1);
  float* wdec = (float*)(p.ws + OFF_S2);
  bf16_t* aa = (bf16_t*)(p.ws + OFF_AA);
  bf16_t* gg = (bf16_t*)(p.ws + OFF_G);
  for (int w = bid; w < 128 * 24; w += nb) {
    int mt = w % 128, rest = w / 128, which = rest >> 3, nt = rest & 7;
    const int m0 = mt * 128, n0 = nt * 128;
    const int K = which == 2 ? 128 : 64;
    const int aoff = which == 0 ? 0 : (which == 1 ? 64 : 128);
    const bf16_t* Bt = (const bf16_t*)(p.ws + (which == 0 ? OFF_DEC2T : (which == 1 ? OFF_A2T : OFF_G2T)));
    const bf16_t* Ab = lora1 + (size_t)m0 * 256 + aoff;
    const bf16_t* Bb = Bt + (size_t)n0 * K;
    gemm_tile([&](int i, int r, int k) { return *(const bf16x8*)(Ab + (size_t)r * 256 + k); },
              [&](int i, int r, int k) { return *(const bf16x8*)(Bb + (size_t)r * K + k); }, K / 64,
              [&](f32x4(&acc)[4][4], int r0, int c0) {
#pragma unroll
                for (int m = 0; m < 4; ++m) {
                  const int col = n0 + c0;
                  const size_t idx = (size_t)(m0 + r0 + m * 16) * 1024 + col;
                  if (which == 0) {
#pragma unroll
                    for (int n = 0; n < 4; ++n) {
                      float4 o;
                      float* op = (float*)&o;
#pragma unroll
                      for (int j = 0; j < 4; ++j) {
                        float wl = -__logf(1.f + __expf(-(p.dec0[col + n * 4 + j] + acc[m][n][j]))) - 0.5f;
                        op[j] = __expf(-__expf(wl));
                      }
                      *(float4*)(wdec + idx + n * 4) = o;
                    }
                  } else if (which == 1) {
#pragma unroll
                    for (int n = 0; n < 4; ++n)
#pragma unroll
                      for (int j = 0; j < 4; ++j) acc[m][n][j] = sigmoidf_(p.a0[col + n * 4 + j] + acc[m][n][j]);
                    store16(aa + idx, acc[m]);
                  } else {
                    store16(gg + idx, acc[m]);
                  }
                }
              },
              smem);
  }
}

__device__ __forceinline__ void ph_prep1(const P& p, int bid, int nb) {
  const int lane = TIDX & 63, wid = TIDX >> 6;
  const bf16_t* R = (const bf16_t*)(p.ws + OFF_R);
  bf16_t* Kb = (bf16_t*)(p.ws + OFF_K);
  bf16_t* KK = (bf16_t*)(p.ws + OFF_KK);
  const bf16_t* AA = (const bf16_t*)(p.ws + OFF_AA);
  float* bonus = (float*)(p.ws + OFF_BONUS);
  const int c0 = lane * 16;
  for (int t = bid * 4 + wid; t < T; t += nb * 4) {
    size_t base = (size_t)t * 1024 + c0;
    float kv[16], av[16], rv[16];
#pragma unroll
    for (int i = 0; i < 2; ++i) {
      bf16x8 k8 = *(const bf16x8*)(Kb + base + i * 8), a8 = *(const bf16x8*)(AA + base + i * 8),
             r8 = *(const bf16x8*)(R + base + i * 8);
#pragma unroll
      for (int j = 0; j < 8; ++j) {
        kv[i * 8 + j] = bfs2f(k8[j]);
        av[i * 8 + j] = bfs2f(a8[j]);
        rv[i * 8 + j] = bfs2f(r8[j]);
      }
    }
    float kkv[16], kh[16];
    float ss = 0.f, bon = 0.f;
#pragma unroll
    for (int j = 0; j < 16; ++j) {
      kkv[j] = kv[j] * p.k_k[c0 + j];
      ss += kkv[j] * kkv[j];
      kh[j] = kv[j] * (1.f + (av[j] - 1.f) * p.k_a[c0 + j]);
      bon += rv[j] * kh[j] * p.r_k[c0 + j];
    }
    ss += __shfl_xor(ss, 1, 64);
    ss += __shfl_xor(ss, 2, 64);
    bon += __shfl_xor(bon, 1, 64);
    bon += __shfl_xor(bon, 2, 64);
    float inv = 1.f / fmaxf(sqrtf(ss), 1e-12f);
#pragma unroll
    for (int i = 0; i < 2; ++i) {
      bf16x8 o1, o2;
#pragma unroll
      for (int j = 0; j < 8; ++j) {
        o1[j] = (short)f2bf(kkv[i * 8 + j] * inv);
        o2[j] = (short)f2bf(kh[i * 8 + j]);
      }
      *(bf16x8*)(KK + base + i * 8) = o1;
      *(bf16x8*)(Kb + base + i * 8) = o2;
    }
    if ((lane & 3) == 0) bonus[(size_t)t * 16 + (lane >> 2)] = bon;
  }
}

struct ScanRegs {
  bf16x4 r, k, a;
  f32x4 w;
  bf16_t v;
};
constexpr int SCAN_STEP = 336;

__device__ __forceinline__ void scan1_unit(const P& p, int u, char* smem) {
  const int tfull = tid_fresh();
  const bool loader = (tfull >> 8) != 0;
  const int tid = tfull & 255, lane = tid & 63, w = tid >> 6;
  const int bh = u >> 2, rg = u & 3, b = bh >> 4, hd = bh & 15;
  const bf16_t* R = (const bf16_t*)(p.ws + OFF_R);
  bf16_t* Yo = (bf16_t*)(p.ws + OFF_S1);
  const bf16_t* Kb = (const bf16_t*)(p.ws + OFF_K);
  const bf16_t* V = (const bf16_t*)(p.ws + OFF_V);
  const bf16_t* AA = (const bf16_t*)(p.ws + OFF_AA);
  const float* W = (const float*)(p.ws + OFF_S2);
  float* bonus = (float*)(p.ws + OFF_BONUS);
  float* buf0 = (float*)smem;
  float* buf1 = buf0 + 16 * SCAN_STEP;
  float* yb0 = buf1 + 16 * SCAN_STEP;
  float* yb1 = yb0 + 256;
  const int ks = (lane & 15) * 4, rl = w * 4 + (lane >> 4);
  const int st_l = tid >> 4, k0 = (tid & 15) * 4, rr = tid & 15;
  const size_t gbase = (size_t)b * SEQ * 1024 + hd * 64;
  if (loader) {
    const f32x4 kkp = *(const f32x4*)(p.k_k + hd * 64 + k0), kap = *(const f32x4*)(p.k_a + hd * 64 + k0),
                rkp = *(const f32x4*)(p.r_k + hd * 64 + k0);
    auto gload = [&](int t0, ScanRegs& g) {
      const size_t o = gbase + (size_t)(t0 + st_l) * 1024;
      g.r = *(const bf16x4*)(R + o + k0);
      g.k = *(const bf16x4*)(Kb + o + k0);
      g.a = *(const bf16x4*)(AA + o + k0);
      g.w = *(const f32x4*)(W + o + k0);
      g.v = V[o + rg * 16 + rr];
    };
    auto lwrite = [&](float* buf, const ScanRegs& g, int t0) {
      float* d = buf + st_l * SCAN_STEP;
      f32x4 rf, kf, af;
#pragma unroll
      for (int j = 0; j < 4; ++j) {
        rf[j] = bfs2f(g.r[j]);
        kf[j] = bfs2f(g.k[j]);
        af[j] = bfs2f(g.a[j]);
      }
      const f32x4 kkv = kf * kkp;
      const f32x4 kh = kf * ((af - 1.f) * kap + 1.f);
      const f32x4 sq = kkv * kkv, bq = rf * kh * rkp;
      float ss = (sq[0] + sq[1]) + (sq[2] + sq[3]);
      float bon = (bq[0] + bq[1]) + (bq[2] + bq[3]);
      ss = row16_sum(ss);
      bon = row16_sum(bon);
      const float inv = 1.f / fmaxf(sqrtf(ss), 1e-12f);
      const f32x4 r4 = rf, k4 = kh, n4 = kkv * (-inv), b4 = kkv * af * inv;
      *(f32x4*)(d + k0) = r4;
      *(f32x4*)(d + 64 + k0) = g.w;
      *(f32x4*)(d + 128 + k0) = k4;
      *(f32x4*)(d + 192 + k0) = n4;
      *(f32x4*)(d + 256 + k0) = b4;
      d[320 + rr] = bf2f(g.v);
      if (rg == 0 && rr == 0) bonus[((size_t)b * SEQ + t0 + st_l) * 16 + hd] = bon;
    };
    auto ystore = [&](int t0, const float* yb) {
      Yo[gbase + (size_t)(t0 + st_l) * 1024 + rg * 16 + rr] = f2bf(yb[st_l * 16 + rr]);
    };
    float* ctile = (float*)(smem + 65536) + w * (64 * 33);
    const float* cw1 = p.moe_w1 + (size_t)16 * 524288;
    const float* cw3 = p.moe_w3 + (size_t)16 * 524288;
    const float* cw2 = p.moe_w2 + (size_t)16 * 524288;
    bf16_t* cd13 = (bf16_t*)(p.ws + OFF_W13T_L1);
    bf16_t* cd2 = (bf16_t*)(p.ws + OFF_W2T_L1);
    constexpr int CNT = 16 * 768;
    const int clr = lane >> 3, clc = (lane & 7) * 4, ckc = lane & 7;
    auto cload = [&](int gi, f32x4 (&v)[8]) {
      const int e = gi / 768, r = gi - e * 768, which = r >> 8, tt = r & 255;
      const float* src = (which == 0 ? cw1 : (which == 1 ? cw3 : cw2)) + (size_t)e * 524288;
      const int ld = which == 2 ? 1024 : 512;
      const int k0c = which == 2 ? (tt >> 5) * 64 : (tt >> 4) * 64, n0c = which == 2 ? (tt & 31) * 32 : (tt & 15) * 32;
#pragma unroll
      for (int i = 0; i < 8; ++i) v[i] = *(const f32x4*)(src + (size_t)(k0c + clr + 8 * i) * ld + n0c + clc);
    };
    auto cstore = [&](int gi, const f32x4 (&v)[8]) {
      const int e = gi / 768, r = gi - e * 768, which = r >> 8, tt = r & 255;
      const int k0c = which == 2 ? (tt >> 5) * 64 : (tt >> 4) * 64, n0c = which == 2 ? (tt & 31) * 32 : (tt & 15) * 32;
#pragma unroll
      for (int i = 0; i < 8; ++i) {
        float* d = ctile + (clr + 8 * i) * 33 + clc;
        d[0] = v[i][0];
        d[1] = v[i][1];
        d[2] = v[i][2];
        d[3] = v[i][3];
      }
      __builtin_amdgcn_wave_barrier();
#pragma unroll
      for (int q = 0; q < 4; ++q) {
        const int n = n0c + (lane >> 3) + 8 * q;
        bf16_t* drow = which == 2 ? cd2 + (size_t)e * 524288 + (size_t)n * 512 + k0c
                                  : cd13 + (size_t)e * 1048576 + (size_t)((n >> 4) * 32 + which * 16 + (n & 15)) * 1024 + k0c;
        const float* tq = ctile + ckc * 8 * 33 + (lane >> 3) + 8 * q;
        const bf16x8 o = pack8(tq[0], tq[33], tq[66], tq[99], tq[132], tq[165], tq[198], tq[231]);
        *(bf16x8*)(drow + ckc * 8) = o;
      }
      __builtin_amdgcn_wave_barrier();
    };
    int cg = (int)blockIdx.x * 4 + w;
    bool cpend = false;
    f32x4 cva[8];
    ScanRegs g0, g1;
    gload(0, g0);
    __syncthreads();
    lwrite(buf0, g0, 0);
    gload(16, g0);
    gload(32, g1);
    __syncthreads();
    auto liter = [&](int bt, ScanRegs& g) {
      float* nb_ = (bt & 1) ? buf0 : buf1;
      float* yprev = (bt & 1) ? yb0 : yb1;
      if (bt + 1 < 256) lwrite(nb_, g, (bt + 1) * 16);
      if (bt + 3 < 256) gload((bt + 3) * 16, g);
      if (bt > 0) ystore((bt - 1) * 16, yprev);
      if ((bt & 7) == 6 && cpend) {
        cstore(cg, cva);
        cpend = false;
        cg += 1024;
      }
      if ((bt & 7) == 2 && cg < CNT) {
        cload(cg, cva);
        cpend = true;
      }
      __syncthreads();
    };
#pragma unroll 1
    for (int bt = 0; bt < 256; bt += 2) {
      liter(bt, g0);
      liter(bt + 1, g1);
    }
    ystore(255 * 16, yb1);
    while (cg < CNT) {
      cload(cg, cva);
      cstore(cg, cva);
      cg += 1024;
    }
  } else {
    f32x2 S01 = {0.f, 0.f}, S23 = {0.f, 0.f};
    auto compute = [&](const float* buf, float* yb) {
      const float* sp0 = buf + ks;
      f32x4 nk = *(const f32x4*)(sp0 + 192), wv = *(const f32x4*)(sp0 + 64), kv = *(const f32x4*)(sp0 + 128),
            bt = *(const f32x4*)(sp0 + 256), rv = *(const f32x4*)(sp0);
      float vv = buf[320 + rl];
      float ykeep = 0.f;
#pragma unroll 4
      for (int st = 0; st < 16; ++st) {
        const float* sp = sp0 + (st + 1) * SCAN_STEP;
        f32x4 nk2 = *(const f32x4*)(sp + 192), wv2 = *(const f32x4*)(sp + 64), kv2 = *(const f32x4*)(sp + 128),
              bt2 = *(const f32x4*)(sp + 256), rv2 = *(const f32x4*)(sp);
        float vv2 = buf[(st + 1) * SCAN_STEP + 320 + rl];
        const f32x2 vvv = {vv, vv};
        f32x2 pa = S01 * nk.xy;
        pa = S23 * nk.zw + pa;
        f32x2 t01 = S01 * wv.xy, t23 = S23 * wv.zw;
        t01 = vvv * kv.xy + t01;
        t23 = vvv * kv.zw + t23;
        const float sa = row16_sum(pa.x + pa.y);
        const f32x2 sav = {sa, sa};
        S01 = sav * bt.xy + t01;
        S23 = sav * bt.zw + t23;
        f32x2 qy = S01 * rv.xy;
        qy = S23 * rv.zw + qy;
        const float y = row16_sum(qy.x + qy.y);
        ykeep = ((lane & 15) == st) ? y : ykeep;
        asm volatile("" : "+v"(nk2), "+v"(wv2), "+v"(kv2), "+v"(bt2), "+v"(rv2), "+v"(vv2));
        nk = nk2; wv = wv2; kv = kv2; bt = bt2; rv = rv2; vv = vv2;
      }
      yb[(lane & 15) * 16 + rl] = ykeep;
    };
    __syncthreads();
    __syncthreads();
    __builtin_amdgcn_s_setprio(3);
    for (int bt = 0; bt < 256; ++bt) {
      compute((bt & 1) ? buf1 : buf0, (bt & 1) ? yb1 : yb0);
      __syncthreads();
    }
    __builtin_amdgcn_s_setprio(0);
  }
}

__device__ __forceinline__ void ph_scan1(const P& p, int bid, int nb, char* smem) {
  const int u = (int)blockIdx.x;
  if (u < 256) scan1_unit(p, u, smem - ((tid_fresh() >> 8) * 65536));
}

__device__ __forceinline__ void ph_post1(const P& p, int bid, int nb) {
  const int lane = TIDX & 63, wid = TIDX >> 6;
  const bf16_t* Y = (const bf16_t*)(p.ws + OFF_S1);
  const bf16_t* V = (const bf16_t*)(p.ws + OFF_V);
  const bf16_t* G = (const bf16_t*)(p.ws + OFF_G);
  const float* bonus = (const float*)(p.ws + OFF_BONUS);
  bf16_t* o = (bf16_t*)(p.ws + OFF_S1);
  const int c0 = lane * 16;
  for (int t = bid * 4 + wid; t < T; t += nb * 4) {
    size_t base = (size_t)t * 1024 + c0;
    float yv[16], vv[16], gv[16];
    float s = 0.f;
#pragma unroll
    for (int i = 0; i < 2; ++i) {
      bf16x8 y8 = *(const bf16x8*)(Y + base + i * 8), v8 = *(const bf16x8*)(V + base + i * 8),
             g8 = *(const bf16x8*)(G + base + i * 8);
#pragma unroll
      for (int j = 0; j < 8; ++j) {
        yv[i * 8 + j] = bfs2f(y8[j]);
        vv[i * 8 + j] = bfs2f(v8[j]);
        gv[i * 8 + j] = bfs2f(g8[j]);
        s += yv[i * 8 + j];
      }
    }
    s += __shfl_xor(s, 1, 64);
    s += __shfl_xor(s, 2, 64);
    float mean = s * (1.f / 64.f);
    float var = 0.f;
#pragma unroll
    for (int j = 0; j < 16; ++j) var += (yv[j] - mean) * (yv[j] - mean);
    var += __shfl_xor(var, 1, 64);
    var += __shfl_xor(var, 2, 64);
    float rstd = rsqrtf(var * (1.f / 64.f) + 64e-5f);
    float bon = bonus[(size_t)t * 16 + (lane >> 2)];
#pragma unroll
    for (int i = 0; i < 2; ++i) {
      bf16x8 o8;
#pragma unroll
      for (int j = 0; j < 8; ++j) {
        int c = c0 + i * 8 + j;
        float val = (yv[i * 8 + j] - mean) * rstd * p.ln_w[c] + p.ln_b[c] + bon * vv[i * 8 + j];
        o8[j] = (short)f2bf(val * gv[i * 8 + j]);
      }
      *(bf16x8*)(o + base + i * 8) = o8;
    }
  }
}

__device__ __forceinline__ void ph_final(const P& p, int bid, int nb) {
  const int lane = TIDX & 63, wid = TIDX >> 6;
  for (int t = bid * 4 + wid; t < T; t += nb * 4) {
    float4* xr = (float4*)(p.out + (size_t)t * 1024);
    float4 v[4];
    float ss = 0;
#pragma unroll
    for (int i = 0; i < 4; ++i) {
      v[i] = xr[lane + 64 * i];
      ss += v[i].x * v[i].x + v[i].y * v[i].y + v[i].z * v[i].z + v[i].w * v[i].w;
    }
    ss = wave_sum(ss);
    float rstd = rsqrtf(ss * (1.f / 1024.f) + 1e-6f);
    if (PROBE_MASK != 0) {
      const unsigned long long* ts = (const unsigned long long*)(p.ws + OFF_TS);
      unsigned long long sel = 0;
#pragma unroll
      for (int k = 0; k < 21; ++k)
        if ((PROBE_MASK >> k) & 1) sel += ts[k + 1] - ts[k];
      rstd *= 1.f + 10.f * ((float)sel / (float)(ts[21] - ts[0]));
    }
#pragma unroll
    for (int i = 0; i < 4; ++i) {
      float4 w4 = *(const float4*)(p.final_w + (lane + 64 * i) * 4);
      float4 o;
      o.x = v[i].x * rstd * w4.x;
      o.y = v[i].y * rstd * w4.y;
      o.z = v[i].z * rstd * w4.z;
      o.w = v[i].w * rstd * w4.w;
      xr[lane + 64 * i] = o;
    }
  }
}


#define AS1 __attribute__((address_space(1)))
template <int PH, class T>
__device__ __forceinline__ T* launder(T* ptr) {
  AS1 T* g = (AS1 T*)ptr;
  asm("; phase %1" : "+s"(g) : "i"(PH));
  return (T*)g;
}
template <int PH>
__device__ __forceinline__ P launder_params(const P& q) {
  P r;
  const float* const* src = (const float* const*)&q;
  const float** dst = (const float**)&r;
#pragma unroll
  for (int i = 0; i < 37; ++i) dst[i] = launder<PH>(src[i]);
  r.out = launder<PH>(q.out);
  r.ws = launder<PH>(q.ws);
  return r;
}

constexpr int NPHASE = 25;
template <int PH>
__device__ __forceinline__ void run_phase(const P& p0, int bid, int nb, char* smem, LAS unsigned char* lds) {
  const P p = launder_params<PH>(p0);
  const float* mod = (const float*)(p.ws + OFF_MOD);
  if (PH == 0) { ph_prep(p, bid, nb, smem); __syncthreads(); ph_conv_w0(p, bid, nb, smem); __syncthreads(); }
  else if (PH == 1) ph_norm0(p, bid, nb, smem);
  else if (PH == 2) ph8_inproj(p, lds);
  else if (PH == 3) {}
  else if (PH == 4) ph_mixA(p, bid, nb, smem);
  else if (PH == 5) ph_mixS(p, bid, nb);
  else if (PH == 21) ph_mixB(p, bid, nb, smem, 0);
  else if (PH == 6) ph8_outproj(p, lds);
  else if (PH == 7) { ph_conv_moe(p, 0, bid, nb, smem); ph_conv_w1(p, bid, nb, smem); __syncthreads(); ph_route(p, 0, bid, nb, smem); __syncthreads(); }
  else if (PH == 8) ph8_moe_up(p, 0, lds);
  else if (PH == 9) ph8_moe_down(p, 0, lds);
  else if (PH == 10) ph_norm1(p, bid, nb, smem);
  else if (PH == 11) { ph8_rkv(p, lds); ph_gemm_rkv(p, bid, nb, smem); }
  else if (PH == 12) ph_gemm_lora2(p, bid, nb, smem);
  else if (PH == 13) {}
  else if (PH == 14) ph_scan1(p, bid, nb, smem);
  else if (PH == 15) ph_post1(p, bid, nb);
  else if (PH == 16) ph8_wo(p, lds);
  else if (PH == 17) { ph_route(p, 1, bid, nb, smem); }
  else if (PH == 18) ph8_moe_up(p, 1, lds);
  else if (PH == 19) ph8_moe_down(p, 1, lds);
  else if (PH == 20) ph_final(p, bid, nb);
}

#define XB_TMO      128
#define XB_XCNT(j)  (256  + 64 * (j))
#define XB_XSUB(j)  (1280 + 64 * (j))
#define XB_XGEN(j)  (2304 + 64 * (j))
#define XB_TOP      3328
#define XB_TOPGEN   3392
#define XCD_BAR_WORDS 3456
#define XB_SPIN_CAP (1u << 18)

__device__ __forceinline__ unsigned xb_ld(unsigned* p)              { return __hip_atomic_load(p, __ATOMIC_RELAXED, __HIP_MEMORY_SCOPE_AGENT); }
__device__ __forceinline__ unsigned xb_add(unsigned* p, unsigned v) { return __hip_atomic_fetch_add(p, v, __ATOMIC_RELAXED, __HIP_MEMORY_SCOPE_AGENT); }
__device__ __forceinline__ unsigned xb_xcc_id() { return (unsigned)__builtin_amdgcn_s_getreg((3 << 11) | 20) & 0xFu; }
#define XB_SPIN(cond, bar) do { unsigned _sp = 0; while (cond) { __builtin_amdgcn_s_sleep(1); \
    if ((++_sp & 255u) == 0u) { if (xb_ld(&(bar)[XB_TMO])) break; if (_sp > XB_SPIN_CAP) { atomicAdd(&(bar)[XB_TMO], 1u); break; } } } } while (0)

struct XcdBarrier {
    unsigned* bar; unsigned x;
    volatile LAS unsigned* st;
};

__device__ __forceinline__ XcdBarrier xcd_barrier_post(unsigned* bar, volatile LAS unsigned* st) {
    XcdBarrier b; b.bar = bar; b.x = xb_xcc_id(); b.st = st;
    if (threadIdx.x == 0) (void)xb_add(&bar[XB_XCNT(b.x)], 1u);
    return b;
}
__device__ __forceinline__ void xcd_barrier_complete(unsigned* bar, unsigned x, unsigned& nloc, unsigned& nx) {
    const unsigned G = gridDim.x * gridDim.y * gridDim.z;
    unsigned sum, cnt, mine, sp = 0u;
    for (;;) {
        sum = 0u; cnt = 0u; mine = 0u;
#pragma unroll
        for (unsigned j = 0; j < 16; ++j) { const unsigned c = xb_ld(&bar[XB_XCNT(j)]); sum += c; cnt += (c > 0u) ? 1u : 0u; mine = (j == x) ? c : mine; }
        if (sum == G) break;
        __builtin_amdgcn_s_sleep(1);
        if ((++sp & 255u) == 0u) { if (xb_ld(&bar[XB_TMO])) break; if (sp > XB_SPIN_CAP) { atomicAdd(&bar[XB_TMO], 1u); break; } }
    }
    nloc = mine > 0u ? mine : 1u; nx = cnt > 0u ? cnt : 1u;
}

__device__ __forceinline__ void xcd_barrier(const XcdBarrier& b) {
    asm volatile("s_waitcnt vmcnt(0)" ::: "memory");
    __syncthreads();
    if (threadIdx.x == 0) {
        unsigned* bar = b.bar;
        __builtin_amdgcn_s_waitcnt(0);
        unsigned nloc = b.st[0], nx = b.st[1];
        if (nloc == 0u) { xcd_barrier_complete(bar, b.x, nloc, nx); b.st[0] = nloc; b.st[1] = nx; }
        const unsigned old = xb_add(&bar[XB_XSUB(b.x)], 1u);
        const unsigned gen = old / nloc;
        if (old + 1u == (gen + 1u) * nloc) {
            __builtin_amdgcn_fence(__ATOMIC_RELEASE, "agent");
            asm volatile("s_waitcnt vmcnt(0)" ::: "memory");
            const unsigned og = xb_add(&bar[XB_TOP], 1u);
            const unsigned tg = og / nx;
            if (og + 1u == (tg + 1u) * nx) xb_add(&bar[XB_TOPGEN], 1u);
            else XB_SPIN(xb_ld(&bar[XB_TOPGEN]) == tg, bar);
            __builtin_amdgcn_fence(__ATOMIC_ACQUIRE, "agent");
            xb_add(&bar[XB_XGEN(b.x)], 1u);
            asm volatile("s_waitcnt vmcnt(0)" ::: "memory");
        } else {
            XB_SPIN(xb_ld(&bar[XB_XGEN(b.x)]) == gen, bar);
            __builtin_amdgcn_fence(__ATOMIC_ACQUIRE, "agent");
            asm volatile("s_waitcnt vmcnt(0)" ::: "memory");
        }
    }
    __syncthreads();
}


namespace cg = cooperative_groups;

__device__ __forceinline__ void probe_stamp(const P& p, int slot) {
  if (PROBE_MASK != 0 && blockIdx.x == 0 && threadIdx.x == 0) {
    unsigned long long* ts = (unsigned long long*)(p.ws + OFF_TS);
    ts[slot] = wall_clock64();
  }
}


template <int PH, int SLOT>
__device__ __forceinline__ void run_all(const P& p, int bid, int nb, char* smem, LAS unsigned char* lds, const XcdBarrier& xb) {
  if constexpr (PH == 13 || PH == 3) {
    run_all<PH + 1, SLOT + 1>(p, bid, nb, smem, lds, xb);
  } else if constexpr (PH < 21) {
    run_phase<PH>(p, bid, nb, smem, lds);
    if constexpr (PH < 20) {
      if constexpr (PH == 19) probe_stamp(p, SLOT + 1);
      xcd_barrier(xb);
      if constexpr (PH != 19) probe_stamp(p, SLOT + 1);
    }
    if constexpr (PH == 5) {
      run_phase<21>(p, bid, nb, smem, lds);
      xcd_barrier(xb);
      probe_stamp(p, SLOT + 2);
      run_all<PH + 1, SLOT + 2>(p, bid, nb, smem, lds, xb);
    } else {
      run_all<PH + 1, SLOT + 1>(p, bid, nb, smem, lds, xb);
    }
  }
}

constexpr int DYN_LDS = 131072 + 64;

__global__ void __launch_bounds__(512, 2) mega(P p) {
  extern __shared__ __attribute__((aligned(16))) char dsm[];
  if (p.ws == nullptr) cg::this_grid().sync();
  volatile LAS unsigned* st = (volatile LAS unsigned*)(dsm + 131072);
  if (threadIdx.x == 0) {
    st[0] = 0u;
    st[1] = 0u;
    st[2] = 0u;
    st[3] = 0u;
  }
  __syncthreads();
  XcdBarrier xb = xcd_barrier_post((unsigned*)(p.ws + OFF_BAR), st);
  probe_stamp(p, 0);
  const int vb = threadIdx.x >> 8;
  run_all<0, 0>(p, (int)blockIdx.x * 2 + vb, (int)gridDim.x * 2, dsm + vb * 65536, (LAS unsigned char*)dsm, xb);
}

extern "C" void kernel_launch(void* const* d_in, const int* in_sizes, int n_in, void* d_out, int out_size, void* d_ws,
                              size_t ws_size, hipStream_t stream) {
  P p{};
  const float** pp = (const float**)&p;
  for (int i = 0; i < 37; ++i) pp[i] = (const float*)d_in[i];
  p.out = (float*)d_out;
  p.ws = (char*)d_ws;
  if (ws_size < WS_NEED) fprintf(stderr, "workspace too small: %zu < %zu\n", ws_size, (size_t)WS_NEED);
  static int grid_blocks = 0;
  if (!grid_blocks) {
    int dev = 0, cus = 0, per_cu = 0;
    hipGetDevice(&dev);
    hipDeviceGetAttribute(&cus, hipDeviceAttributeMultiprocessorCount, dev);
    hipFuncSetAttribute((const void*)mega, hipFuncAttributeMaxDynamicSharedMemorySize, DYN_LDS);
    hipOccupancyMaxActiveBlocksPerMultiprocessor(&per_cu, mega, 512, DYN_LDS);
    if (per_cu > 1) per_cu = 1;
    if (per_cu < 1) per_cu = 1;
    grid_blocks = cus * per_cu;
  }
  hipMemsetAsync((char*)d_ws + OFF_BAR, 0, BAR_MEMSET_BYTES, stream);
  void* args[] = {&p};
  hipError_t e = hipLaunchCooperativeKernel((void*)mega, dim3(grid_blocks), dim3(512), args, DYN_LDS, stream);
  if (e != hipSuccess) fprintf(stderr, "cooperative launch failed: %s (grid %d)\n", hipGetErrorString(e), grid_blocks);
}
```
